# Optimizing an MI355X kernel written in HIP

```python
import jax, jax.numpy as jnp
from jax import lax
import numpy as np


D_MODEL = 1024
BATCH = 16
SEQ = 256
DEPTH = 4
DEC_BATCH = 2
DEC_SEQ = 4096
PAST_LEN = 512

GRID_W = 64
GROUP_W = 256
D_MIX = 4 * GROUP_W
HEAD_DIM = 64
A_HEADS = 4
CHUNK = 128
C_Q_HEADS = 4
C_KV_HEADS = 2
C_GROUPS = C_Q_HEADS // C_KV_HEADS
WINDOW = 128
QBLK = 128
D_HEADS = 4
WIN_R = 8
WIN_C = 16
CONV_W = 3
ROPE_BASE = 10000.0
EPS = 1e-6
NEG = -1e30
SPLIT_SIZES = (GROUP_W, GROUP_W, GROUP_W,
               GROUP_W, GROUP_W, GROUP_W, GROUP_W,
               C_Q_HEADS * HEAD_DIM, C_KV_HEADS * HEAD_DIM, C_KV_HEADS * HEAD_DIM, GROUP_W,
               D_HEADS * HEAD_DIM, D_HEADS * HEAD_DIM, D_HEADS * HEAD_DIM, GROUP_W)
D_IN = 7 * GROUP_W + (C_Q_HEADS + 2 * C_KV_HEADS) * HEAD_DIM + GROUP_W + 3 * D_HEADS * HEAD_DIM + GROUP_W

kernel_name = 'hybrid_diffusion_denoise_step'


def rmsnorm(x, g):
    xf = x.astype(jnp.float32)
    y = xf * lax.rsqrt(jnp.mean(xf * xf, axis=-1, keepdims=True) + EPS)
    return (y * g.astype(jnp.float32)).astype(x.dtype)


def modulate(x, cond, g, w_mod, b_mod):
    mod = jax.nn.silu(cond) @ w_mod + b_mod
    shift, scale, gate = jnp.split(mod[:, None, :], 3, axis=-1)
    return rmsnorm(x, g) * (1 + scale) + shift, gate


def split_proj(p):
    idx = [int(i) for i in np.cumsum(SPLIT_SIZES)[:-1]]
    return jnp.split(p, idx, axis=-1)


def rope1d(x, pos):
    half = x.shape[-1] // 2
    freqs = ROPE_BASE ** (-jnp.arange(half, dtype=jnp.float32) / half)
    ang = pos.astype(jnp.float32)[:, None] * freqs
    cos = jnp.cos(ang)[:, None, :].astype(x.dtype)
    sin = jnp.sin(ang)[:, None, :].astype(x.dtype)
    x1, x2 = x[..., :half], x[..., half:]
    return jnp.concatenate([x1 * cos - x2 * sin, x1 * sin + x2 * cos], axis=-1)


def rope2d(x):
    t = jnp.arange(x.shape[1])
    half = x.shape[-1] // 2
    return jnp.concatenate([rope1d(x[..., :half], t // GRID_W),
                            rope1d(x[..., half:], t % GRID_W)], axis=-1)


def sink_softmax(s, sink):
    s = s.astype(jnp.float32)
    sink = sink.astype(jnp.float32)
    m = jnp.maximum(jnp.max(s, axis=-1, keepdims=True), sink)
    e = jnp.exp(s - m)
    return e / (jnp.sum(e, axis=-1, keepdims=True) + jnp.exp(sink - m))


def chunk_mlp(u, v, w_s, b_s):
    B, T, _ = v.shape
    n = T // CHUNK
    vh = v.reshape(B, n, CHUNK, A_HEADS, HEAD_DIM)
    vf = vh.astype(jnp.float32)
    vh = (vf * lax.rsqrt(jnp.mean(vf * vf, axis=-1, keepdims=True) + EPS)).astype(v.dtype)
    mixed = jnp.einsum('hpq,bnqhd->bnphd', w_s, vh) + b_s.T[None, None, :, :, None]
    return u * mixed.reshape(B, T, GROUP_W)


def short_conv(bg, cg, h, w_conv):
    xc = cg * h
    xp = jnp.pad(xc, ((0, 0), (1, 1), (0, 0)))
    y = w_conv[0] * xp[:, :-2] + w_conv[1] * xp[:, 1:-1] + w_conv[2] * xp[:, 2:]
    return bg * y


def dense_attn(q, k, v, sink):
    B, L, Hkv, G, dh = q.shape
    nb = L // QBLK
    scale = dh ** -0.5
    qb = jnp.moveaxis(q.reshape(B, nb, QBLK, Hkv, G, dh), 1, 0)

    def block(qi):
        s = jnp.einsum('bqhgd,bkhd->bhgqk', qi, k).astype(jnp.float32) * scale
        if sink is None:
            p = jax.nn.softmax(s, axis=-1)
        else:
            p = sink_softmax(s, sink.reshape(Hkv, G)[None, :, :, None, None])
        return jnp.einsum('bhgqk,bkhd->bqhgd', p.astype(v.dtype), v)

    o = lax.map(block, qb)
    return jnp.moveaxis(o, 0, 1).reshape(B, L, Hkv * G * dh)


def window_attn(q, k, v, kc, vc, sink):
    B, T, Hq, dh = q.shape
    nb = T // QBLK
    scale = dh ** -0.5
    qb = q.reshape(B, nb, QBLK, C_KV_HEADS, C_GROUPS, dh)
    pad = ((0, 0), (QBLK, QBLK), (0, 0), (0, 0))
    kp = jnp.pad(k, pad).reshape(B, nb + 2, QBLK, C_KV_HEADS, dh)
    vp = jnp.pad(v, pad).reshape(B, nb + 2, QBLK, C_KV_HEADS, dh)
    kw = jnp.concatenate([kp[:, :-2], kp[:, 1:-1], kp[:, 2:]], axis=2)
    vw = jnp.concatenate([vp[:, :-2], vp[:, 1:-1], vp[:, 2:]], axis=2)
    n = np.arange(nb)[:, None, None]
    p = np.arange(QBLK)[None, :, None]
    j = np.arange(3 * QBLK)[None, None, :]
    kpos = (n - 1) * QBLK + j
    qpos = n * QBLK + p
    mask = jnp.asarray((np.abs(kpos - qpos) <= WINDOW) & (kpos >= 0) & (kpos < T))
    s_loc = jnp.einsum('bnqhgd,bnjhd->bnhgqj', qb, kw).astype(jnp.float32) * scale
    s_loc = jnp.where(mask[None, :, None, None], s_loc, NEG)
    s_ctx = jnp.einsum('bnqhgd,blhd->bnhgql', qb, kc).astype(jnp.float32) * scale
    pr = sink_softmax(jnp.concatenate([s_loc, s_ctx], axis=-1),
                      sink.reshape(C_KV_HEADS, C_GROUPS)[None, None, :, :, None, None]).astype(v.dtype)
    p_loc, p_ctx = pr[..., :3 * QBLK], pr[..., 3 * QBLK:]
    o = (jnp.einsum('bnhgqj,bnjhd->bnqhgd', p_loc, vw)
         + jnp.einsum('bnhgql,blhd->bnqhgd', p_ctx, vc))
    return o.reshape(B, T, Hq * dh)


def neighbourhood_attn(q, k, v, kc, vc, rpb):
    B, T, H, dh = q.shape
    rows = T // GRID_W
    kr = min(WIN_R, rows)
    scale = dh ** -0.5
    qg = q.reshape(B, rows, GRID_W, H, dh)
    kg = k.reshape(B, rows, GRID_W, H, dh)
    vg = v.reshape(B, rows, GRID_W, H, dh)
    cols = np.arange(GRID_W)
    cstart = np.clip(cols - WIN_C // 2, 0, GRID_W - WIN_C)
    col_idx = cstart[:, None] + np.arange(WIN_C)
    dc = col_idx - cols[:, None] + (WIN_C - 1)
    rpb_c = rpb[:, :, dc]

    def one_row(r):
        rs = jnp.clip(r - kr // 2, 0, rows - kr)
        ridx = rs + jnp.arange(kr)
        k_nb = jnp.take(kg, ridx, axis=1)[:, :, col_idx]
        v_nb = jnp.take(vg, ridx, axis=1)[:, :, col_idx]
        qr = lax.dynamic_index_in_dim(qg, r, axis=1, keepdims=False)
        s_loc = jnp.einsum('bchd,brcwhd->bhcrw', qr, k_nb).astype(jnp.float32) * scale
        bias = jnp.transpose(jnp.take(rpb_c, ridx - r + (WIN_R - 1), axis=1), (0, 2, 1, 3))
        s_loc = s_loc + bias[None].astype(jnp.float32)
        s_ctx = jnp.einsum('bchd,blhd->bhcl', qr, kc).astype(jnp.float32) * scale
        s = jnp.concatenate([s_loc.reshape(B, H, GRID_W, kr * WIN_C), s_ctx], axis=-1)
        pr = jax.nn.softmax(s, axis=-1).astype(v.dtype)
        p_loc = pr[..., :kr * WIN_C].reshape(B, H, GRID_W, kr, WIN_C)
        p_ctx = pr[..., kr * WIN_C:]
        return (jnp.einsum('bhcrw,brcwhd->bchd', p_loc, v_nb)
                + jnp.einsum('bhcl,blhd->bchd', p_ctx, vc))

    o = lax.map(one_row, jnp.arange(rows))
    return jnp.moveaxis(o, 0, 1).reshape(B, T, H * dh)


def project(x, cond, g, w_mod, b_mod, w_in):
    h, gate = modulate(x, cond, g, w_mod, b_mod)
    return split_proj(h @ w_in), gate


def branches_ab(parts, w_s, b_s, w_conv):
    au, av, az, bb, bc, bh, bz = parts
    ya = chunk_mlp(au, av, w_s, b_s) * jax.nn.silu(az)
    yb = short_conv(bb, bc, bh, w_conv) * jax.nn.silu(bz)
    return ya, yb


def context_layer(x, c_ctx, g, w_mod, b_mod, w_in, w_out, w_s, b_s, w_conv, sink):
    B, L, _ = x.shape
    parts, gate = project(x, c_ctx[None, :], g, w_mod, b_mod, w_in)
    ya, yb = branches_ab(parts[:7], w_s, b_s, w_conv)
    cq, ck, cv, cz, dq, dk, dv, dz = parts[7:]
    ck = ck.reshape(B, L, C_KV_HEADS, HEAD_DIM)
    cv = cv.reshape(B, L, C_KV_HEADS, HEAD_DIM)
    dk = dk.reshape(B, L, D_HEADS, HEAD_DIM)
    dv = dv.reshape(B, L, D_HEADS, HEAD_DIM)
    yc = dense_attn(cq.reshape(B, L, C_KV_HEADS, C_GROUPS, HEAD_DIM), ck, cv, sink) * jax.nn.silu(cz)
    yd = dense_attn(dq.reshape(B, L, D_HEADS, 1, HEAD_DIM), dk, dv, None) * jax.nn.silu(dz)
    y = jnp.concatenate([ya, yb, yc, yd], axis=-1) @ w_out
    return x + gate * y, ck, cv, dk, dv


def latent_layer(x, c, kc, vc, kd, vd, g, w_mod, b_mod, w_in, w_out, w_s, b_s, w_conv, sink, rpb):
    B, T, _ = x.shape
    parts, gate = project(x, c, g, w_mod, b_mod, w_in)
    ya, yb = branches_ab(parts[:7], w_s, b_s, w_conv)
    cq, ck, cv, cz, dq, dk, dv, dz = parts[7:]
    cq = rope2d(cq.reshape(B, T, C_Q_HEADS, HEAD_DIM))
    ck = rope2d(ck.reshape(B, T, C_KV_HEADS, HEAD_DIM))
    cv = cv.reshape(B, T, C_KV_HEADS, HEAD_DIM)
    yc = window_attn(cq, ck, cv, kc, vc, sink) * jax.nn.silu(cz)
    yd = neighbourhood_attn(dq.reshape(B, T, D_HEADS, HEAD_DIM), dk.reshape(B, T, D_HEADS, HEAD_DIM),
                            dv.reshape(B, T, D_HEADS, HEAD_DIM), kd, vd, rpb) * jax.nn.silu(dz)
    y = jnp.concatenate([ya, yb, yc, yd], axis=-1) @ w_out
    return x + gate * y


def setup_inputs(seed: int = 0) -> dict:
    key = jax.random.key(seed)
    ks = jax.random.split(key, 20)
    nrm = jax.random.normal
    f32 = jnp.float32
    return {
        'x_prompt': nrm(ks[0], (BATCH, SEQ, D_MODEL), f32),
        'x_sample': nrm(ks[1], (DEC_BATCH, DEC_SEQ, D_MODEL), f32),
        'cache_c_k': nrm(ks[2], (DEC_BATCH, DEPTH, PAST_LEN, C_KV_HEADS, HEAD_DIM), f32),
        'cache_c_v': nrm(ks[3], (DEC_BATCH, DEPTH, PAST_LEN, C_KV_HEADS, HEAD_DIM), f32),
        'cache_d_k': nrm(ks[4], (DEC_BATCH, DEPTH, PAST_LEN, D_HEADS, HEAD_DIM), f32),
        'cache_d_v': nrm(ks[5], (DEC_BATCH, DEPTH, PAST_LEN, D_HEADS, HEAD_DIM), f32),
        'c': nrm(ks[6], (DEC_BATCH, D_MODEL), f32),
        'c_ctx': nrm(ks[7], (D_MODEL,), f32),
        'norm_g': 1.0 + 0.02 * nrm(ks[8], (DEPTH, D_MODEL), f32),
        'w_mod': 0.5 * D_MODEL ** -0.5 * nrm(ks[9], (DEPTH, D_MODEL, 3 * D_MODEL), f32),
        'b_mod': 0.02 * nrm(ks[10], (DEPTH, 3 * D_MODEL), f32),
        'w_in': D_MODEL ** -0.5 * nrm(ks[11], (DEPTH, D_MODEL, D_IN), f32),
        'w_out': D_MIX ** -0.5 * nrm(ks[12], (DEPTH, D_MIX, D_MODEL), f32),
        'w_s': CHUNK ** -0.5 * nrm(ks[13], (DEPTH, A_HEADS, CHUNK, CHUNK), f32),
        'b_s': 1.0 + 0.02 * nrm(ks[14], (DEPTH, A_HEADS, CHUNK), f32),
        'w_conv': CONV_W ** -0.5 * nrm(ks[15], (DEPTH, CONV_W, GROUP_W), f32),
        'sink': 0.5 * nrm(ks[16], (DEPTH, C_Q_HEADS), f32),
        'rpb': 0.1 * nrm(ks[17], (DEPTH, D_HEADS, 2 * WIN_R - 1, 2 * WIN_C - 1), f32),
        'final_g': 1.0 + 0.02 * nrm(ks[18], (D_MODEL,), f32),
    }


def reference(x_prompt, x_sample, cache_c_k, cache_c_v, cache_d_k, cache_d_v, c, c_ctx,
              norm_g, w_mod, b_mod, w_in, w_out, w_s, b_s, w_conv, sink, rpb, final_g):
    xp = x_prompt
    xs = x_sample
    ck_list, cv_list, dk_list, dv_list = [], [], [], []
    for l in range(DEPTH):
        xp, ck, cv, dk, dv = context_layer(xp, c_ctx, norm_g[l], w_mod[l], b_mod[l], w_in[l], w_out[l],
                                           w_s[l], b_s[l], w_conv[l], sink[l])
        ck_list.append(ck)
        cv_list.append(cv)
        dk_list.append(dk)
        dv_list.append(dv)
        xs = latent_layer(xs, c, cache_c_k[:, l], cache_c_v[:, l], cache_d_k[:, l], cache_d_v[:, l],
                          norm_g[l], w_mod[l], b_mod[l], w_in[l], w_out[l], w_s[l], b_s[l], w_conv[l],
                          sink[l], rpb[l])
    y_prompt = rmsnorm(xp, final_g)
    y_sample = rmsnorm(xs, final_g)
    state_c_k = jnp.stack(ck_list, axis=1)
    state_c_v = jnp.stack(cv_list, axis=1)
    state_d_k = jnp.stack(dk_list, axis=1)
    state_d_v = jnp.stack(dv_list, axis=1)
    return (y_prompt, y_sample, state_c_k, state_c_v, state_d_k, state_d_v)
```

```cpp
#include <hip/hip_runtime.h>
#include <hip/hip_cooperative_groups.h>
#include <cstdio>
#include <cstdint>
namespace cg = cooperative_groups;
namespace pg8 {
#define PG8_LAS __attribute__((address_space(3)))
#define GAS __attribute__((address_space(1)))
typedef unsigned short bf16_t;
typedef short bf16x8 __attribute__((ext_vector_type(8)));
typedef float f32x4 __attribute__((ext_vector_type(4)));
typedef unsigned u32x4 __attribute__((ext_vector_type(4)));
constexpr int BM = 256, BK = 64, HALF = 128, HTB = HALF * BK * 2  , STAGE_BYTES = 8 * HTB, NXCD = 8, WGM = 8;

__host__ __device__ __forceinline__ int lds_byte(int r, int c) { const int st = (r >> 4) * 2 + (c >> 5), rr = r & 15, cc = c & 31, ob = rr * 64 + cc * 2; return st * 1024 + (ob ^ (((ob >> 9) & 1) << 5)); }
__host__ __device__ __forceinline__ void stage_rc(int b, int& R, int& C) { const int st = b / 1024, sb = b % 1024, swz = sb ^ (((sb >> 9) & 1) << 5); R = (st >> 1) * 16 + swz / 64; C = (st & 1) * 32 + (swz % 64) / 2; }
__host__ __device__ __forceinline__ int perm32(int rho) { const int n = rho >> 4, i = rho & 15; return 8 * (i >> 2) + 4 * n + (i & 3); }

struct Unit { int pm, pn; };
struct Gemm { const bf16_t* A; const bf16_t* Bt; int M, N, K; };

struct StaticOrder {
    int nM, nN, nwg, G, c;
    __host__ __device__ void init(int M, int N, int G_, int c_) { nM = M / BM; nN = N / BM; nwg = nM * nN; G = G_; c = c_; }
    __host__ __device__ bool next(int i, Unit& u) const {
        const long L = (long)i * G + c; if (L >= nwg) return false;
        int wgid = (int)L; { const int q = nwg / NXCD, r = nwg % NXCD, xcd = wgid % NXCD, off = wgid / NXCD; wgid = (xcd < r ? xcd * (q + 1) : r * (q + 1) + (xcd - r) * q) + off; }
        const int nig = WGM * nN, gid = wgid / nig, fm = gid * WGM, gsz = (nM - fm) < WGM ? (nM - fm) : WGM;
        u.pm = fm + ((wgid % nig) % gsz); u.pn = (wgid % nig) / gsz; return true;
    }
    __device__ __forceinline__ void a_ready(const Unit&) const {}
    __device__ __forceinline__ void done(const Unit&) const {}
};
typedef float f32x2cv __attribute__((ext_vector_type(2)));
typedef __bf16 bf16x2cv __attribute__((ext_vector_type(2)));
__device__ __forceinline__ unsigned cvt_pk_bf16(float lo, float hi) { const f32x2cv v = {lo, hi}; const bf16x2cv b = __builtin_convertvector(v, bf16x2cv); return __builtin_bit_cast(unsigned, b); }
constexpr int PROJ_N = 3584;
constexpr size_t OUT_CK = 12582912, OUT_CV = 14680064, OUT_DK = 16777216, OUT_DV = 20971520;
constexpr size_t VTC_LAT = 524288, VTD_LAT = 1048576;

struct EpiProj {
    static constexpr bool PERM = true, AFTER_DRAIN = false;
    bf16_t* P; float* out; bf16_t* VTC; bf16_t* VTD; int layer;
    __device__ __forceinline__ void operator()(const f32x4 (&acc)[2][2][4][2], const Unit& u, int wr, int wc, int fr, int fq) const {
        const int pm = u.pm, pn = u.pn;
        const bool ctx = pm < 16;
        const int rbase = pm * BM + wr * 64 + fr, cbase = pn * BM + wc * 32 + 8 * fq;
        if (!ctx && (pn == 7 || pn == 8)) {
            const float sgn = (fq < 2) ? -1.f : 1.f;
            float frq[8];
#pragma unroll
            for (int e = 0; e < 8; ++e) frq[e] = __builtin_amdgcn_exp2f(-(float)(8 * (fq & 1) + e) * 0.83048202372184058696f) * 0.15915494309189533577f;
#pragma unroll
            for (int ai = 0; ai < 2; ++ai)
#pragma unroll
                for (int m = 0; m < 4; ++m) {
                    const int r = rbase + ai * HALF + m * 16, t = (r - 4096) & 4095;
                    const float pos = (float)((wc & 1) ? (t & 63) : (t >> 6));
#pragma unroll
                    for (int bj = 0; bj < 2; ++bj) {
                        f32x4 v0 = acc[ai][bj][m][0], v1 = acc[ai][bj][m][1];
                        if (pn == 7 || bj == 0) {
                            float o[8];
#pragma unroll
                            for (int e = 0; e < 8; ++e) {
                                const float own = e < 4 ? v0[e] : v1[e - 4];
                                const float oth = __shfl_xor(own, 32);
                                const float rev = pos * frq[e];
                                const float sn = __builtin_amdgcn_sinf(rev), cs = __builtin_amdgcn_cosf(rev);
                                o[e] = own * cs + sgn * oth * sn;
                            }
                            v0 = (f32x4){o[0], o[1], o[2], o[3]}; v1 = (f32x4){o[4], o[5], o[6], o[7]};
                        }
                        u32x4 w; w.x = cvt_pk_bf16(v0[0], v0[1]); w.y = cvt_pk_bf16(v0[2], v0[3]); w.z = cvt_pk_bf16(v1[0], v1[1]); w.w = cvt_pk_bf16(v1[2], v1[3]);
                        *(GAS u32x4*)(P + (size_t)r * PROJ_N + cbase + bj * HALF) = w;
                    }
                }
        } else {
#pragma unroll
            for (int ai = 0; ai < 2; ++ai)
#pragma unroll
                for (int m = 0; m < 4; ++m) {
                    bf16_t* rowp = P + (size_t)(rbase + ai * HALF + m * 16) * PROJ_N + cbase;
#pragma unroll
                    for (int bj = 0; bj < 2; ++bj) {
                        const f32x4 v0 = acc[ai][bj][m][0], v1 = acc[ai][bj][m][1];
                        u32x4 w; w.x = cvt_pk_bf16(v0[0], v0[1]); w.y = cvt_pk_bf16(v0[2], v0[3]); w.z = cvt_pk_bf16(v1[0], v1[1]); w.w = cvt_pk_bf16(v1[2], v1[3]);
                        *(GAS u32x4*)(rowp + bj * HALF) = w;
                    }
                }
        }
        if (ctx && (pn == 8 || pn == 11 || pn == 12)) {
            const int width = pn == 8 ? 128 : 256;
            float* ob0 = out + (pn == 8 ? OUT_CK : pn == 11 ? OUT_DK : OUT_DV);
            float* ob1 = pn == 8 ? out + OUT_CV : ob0 + 128;
            const int coff = wc * 32 + 8 * fq;
#pragma unroll
            for (int ai = 0; ai < 2; ++ai)
#pragma unroll
                for (int m = 0; m < 4; ++m) {
                    const int r = rbase + ai * HALF + m * 16, b = r >> 8, t = r & 255;
                    const size_t ro = ((size_t)((b * 4 + layer) * 256 + t)) * width + coff;
                    *(GAS f32x4*)(ob0 + ro) = acc[ai][0][m][0]; *(GAS f32x4*)(ob0 + ro + 4) = acc[ai][0][m][1];
                    *(GAS f32x4*)(ob1 + ro) = acc[ai][1][m][0]; *(GAS f32x4*)(ob1 + ro + 4) = acc[ai][1][m][1];
                }
        }
        if (pn == 8 || pn == 12) {
            const int T = ctx ? 256 : 4096, nh = pn == 8 ? 2 : 4;
            bf16_t* vb = (pn == 8 ? VTC : VTD) + (ctx ? (size_t)0 : (pn == 8 ? VTC_LAT : VTD_LAT));
#pragma unroll
            for (int bj = 0; bj < 2; ++bj) {
                if (pn == 8 && bj == 0) continue;
                const int cl = (pn == 8 ? 0 : bj * HALF) + wc * 32 + 8 * fq, h = cl >> 6, d0 = cl & 63;
#pragma unroll
                for (int ai = 0; ai < 2; ++ai)
#pragma unroll
                    for (int m = 0; m < 4; ++m) {
                        const int r = rbase + ai * HALF + m * 16;
                        const int b = ctx ? (r >> 8) : ((r - 4096) >> 12), t = ctx ? (r & 255) : ((r - 4096) & 4095);
                        GAS bf16_t* vt = (GAS bf16_t*)(vb + ((size_t)((b * nh + h) * 64 + d0)) * T + t);
                        const f32x4 v0 = acc[ai][bj][m][0], v1 = acc[ai][bj][m][1];
                        const unsigned w0 = cvt_pk_bf16(v0[0], v0[1]), w1 = cvt_pk_bf16(v0[2], v0[3]), w2 = cvt_pk_bf16(v1[0], v1[1]), w3 = cvt_pk_bf16(v1[2], v1[3]);
                        vt[0] = (bf16_t)(w0 & 0xffff); vt[T] = (bf16_t)(w0 >> 16); vt[2 * T] = (bf16_t)(w1 & 0xffff); vt[3 * T] = (bf16_t)(w1 >> 16);
                        vt[4 * T] = (bf16_t)(w2 & 0xffff); vt[5 * T] = (bf16_t)(w2 >> 16); vt[6 * T] = (bf16_t)(w3 & 0xffff); vt[7 * T] = (bf16_t)(w3 >> 16);
                    }
            }
        }
    }
};

struct EpiOut {
    static constexpr bool PERM = true, AFTER_DRAIN = false;
    const float* xin; float* X; const float* gate;
    const float* xin_lat;
    __device__ __forceinline__ void operator()(const f32x4 (&acc)[2][2][4][2], const Unit& u, int wr, int wc, int fr, int fq) const {
#pragma unroll
        for (int ai = 0; ai < 2; ++ai)
#pragma unroll
            for (int m = 0; m < 4; ++m) {
                const int r = u.pm * BM + ai * HALF + wr * 64 + m * 16 + fr;
                const int cond = r < 4096 ? 0 : 1 + ((r - 4096) >> 12);
                const float* xr = r < 4096 ? xin + (size_t)r * 1024 : xin_lat + (size_t)(r - 4096) * 1024;
                const float* gr = gate + cond * 3072;
                float* xo = X + (size_t)r * 1024;
#pragma unroll
                for (int bj = 0; bj < 2; ++bj) {
                    const int c = u.pn * BM + bj * HALF + wc * 32 + 8 * fq;
                    const f32x4 g0 = *(const GAS f32x4*)(gr + c), g1 = *(const GAS f32x4*)(gr + c + 4);
                    const f32x4 x0 = *(const GAS f32x4*)(xr + c), x1 = *(const GAS f32x4*)(xr + c + 4);
                    *(GAS f32x4*)(xo + c) = x0 + g0 * acc[ai][bj][m][0];
                    *(GAS f32x4*)(xo + c + 4) = x1 + g1 * acc[ai][bj][m][1];
                }
            }
    }
};
template <class Epi, class Sched, bool ALIGN_EPI = false, bool SP2 = false>
__device__ __forceinline__ void gemm_phase(PG8_LAS unsigned char* lds, const Gemm g, const Sched& S, const Epi& E) {
    int tid = threadIdx.x; asm volatile("" : "+v"(tid)); const int wid = __builtin_amdgcn_readfirstlane(tid >> 6), lane = tid & 63, wr = wid >> 2, wc = wid & 3, fr = lane & 15, fq = lane >> 4;
    const int K = g.K, nt = K / BK;
    unsigned voffA[2], voffB[2];
#pragma unroll
    for (int i = 0; i < 2; ++i) { int R, C; stage_rc(tid * 16 + i * 8192, R, C); const int Rb = Epi::PERM ? ((R & ~31) + perm32(R & 31)) : R;
        voffA[i] = (unsigned)(R * K + C) * 2u; voffB[i] = (unsigned)(Rb * K + C) * 2u; }
    const size_t kstep = (size_t)(BK * 2);
    const size_t hstep = (size_t)HALF * K * 2;
    const size_t tstep = 2 * hstep;
    const unsigned ldsw = (unsigned)wid * 1024u;
    const int aoff = lds_byte(wr * 64 + fr, fq * 8), boff = lds_byte(wc * 32 + fr, fq * 8);
#define PG8_SA(b, h) (((b) * 2 + (h)) * HTB)
#define PG8_SB(b, h) ((4 + (b) * 2 + (h)) * HTB)
#define PG8_STAGE(bufoff, gbase, voff) do { _Pragma("unroll") for (int _i = 0; _i < 2; ++_i) \
        __builtin_amdgcn_global_load_lds((const unsigned*)((const char*)(gbase) + (voff)[_i]), (PG8_LAS unsigned*)(lds + (bufoff) + ldsw + _i * 8192), 16, 0, 0); } while (0)
#define PG8_LDA(dst, b, h) do { _Pragma("unroll") for (int m = 0; m < 4; ++m) _Pragma("unroll") for (int k = 0; k < 2; ++k) dst[m][k] = *(const PG8_LAS bf16x8*)(lds + PG8_SA(b, h) + aoff + m * 2048 + k * 1024); } while (0)
#define PG8_LDB(dst, b, h) do { _Pragma("unroll") for (int n = 0; n < 2; ++n) _Pragma("unroll") for (int k = 0; k < 2; ++k) dst[n][k] = *(const PG8_LAS bf16x8*)(lds + PG8_SB(b, h) + boff + n * 2048 + k * 1024); } while (0)
#define PG8_MMA(ai, bj, At, Bt) do { __builtin_amdgcn_s_setprio(1); _Pragma("unroll") for (int m = 0; m < 4; ++m) _Pragma("unroll") for (int n = 0; n < 2; ++n) _Pragma("unroll") for (int k = 0; k < 2; ++k) \
        acc[ai][bj][m][n] = __builtin_amdgcn_mfma_f32_16x16x32_bf16(Bt[n][k], At[m][k], acc[ai][bj][m][n], 0, 0, 0); __builtin_amdgcn_s_setprio(0); } while (0)
#define PG8_WAIT_V(n) asm volatile("s_waitcnt vmcnt(" #n ")" ::: "memory")
#define PG8_WAIT_L(n) asm volatile("s_waitcnt lgkmcnt(" #n ")" ::: "memory")
#define PG8_BAR __builtin_amdgcn_s_barrier()
#define PG8_SCHED __builtin_amdgcn_sched_barrier(0)
    Unit cur, nxt; int ui = 0;
    if (!S.next(0, cur)) return;
    f32x4 acc[2][2][4][2];
#pragma unroll
    for (int a = 0; a < 2; ++a)
#pragma unroll
        for (int b = 0; b < 2; ++b)
#pragma unroll
            for (int m = 0; m < 4; ++m)
#pragma unroll
                for (int n = 0; n < 2; ++n) acc[a][b][m][n] = (f32x4){0.f, 0.f, 0.f, 0.f};
    bf16x8 At[4][2], B0[2][2], B1[2][2];
    const char* cA = (const char*)g.A + (size_t)cur.pm * tstep; const char* cB = (const char*)g.Bt + (size_t)cur.pn * tstep;
    S.a_ready(cur);
    if constexpr (SP2) {
        PG8_STAGE(PG8_SB(0, 0), cB, voffB); PG8_STAGE(PG8_SB(0, 1), cB + hstep, voffB); PG8_STAGE(PG8_SA(0, 0), cA, voffA); PG8_STAGE(PG8_SA(0, 1), cA + hstep, voffA);
        if (wr == 1) PG8_BAR;
        PG8_WAIT_V(2); PG8_BAR;
        PG8_STAGE(PG8_SB(1, 0), cB + kstep, voffB); PG8_STAGE(PG8_SA(1, 0), cA + kstep, voffA); PG8_STAGE(PG8_SB(1, 1), cB + hstep + kstep, voffB);
        PG8_WAIT_V(6); PG8_BAR;
    } else {
        PG8_STAGE(PG8_SB(0, 0), cB, voffB); PG8_STAGE(PG8_SA(0, 0), cA, voffA); PG8_STAGE(PG8_SB(0, 1), cB + hstep, voffB); PG8_STAGE(PG8_SA(0, 1), cA + hstep, voffA);
        if (wr == 1) PG8_BAR;
        PG8_WAIT_V(4); PG8_BAR;
        PG8_STAGE(PG8_SB(1, 0), cB + kstep, voffB); PG8_STAGE(PG8_SA(1, 0), cA + kstep, voffA); PG8_STAGE(PG8_SB(1, 1), cB + hstep + kstep, voffB);
        PG8_WAIT_V(6); PG8_BAR;
    }
    for (;;) {
        const bool has_next = S.next(ui + 1, nxt);
        const char* nA = has_next ? (const char*)g.A + (size_t)nxt.pm * tstep : cA; const char* nB = has_next ? (const char*)g.Bt + (size_t)nxt.pn * tstep : cB;
        for (int t = 0; t < nt; t += 2) {
            const bool last = (t == nt - 2);
            const char* a1 = cA + (size_t)(t + 1) * kstep;
            const char* a2 = last ? nA : cA + (size_t)(t + 2) * kstep; const char* b2 = last ? nB : cB + (size_t)(t + 2) * kstep;
            const char* a3 = a2 + kstep; const char* b3 = b2 + kstep;
            if (last && has_next) S.a_ready(nxt);
            if constexpr (SP2) {
            PG8_LDB(B0, 0, 0); PG8_LDB(B1, 0, 1); PG8_SCHED; PG8_LDA(At, 0, 0); PG8_STAGE(PG8_SA(1, 1), a1 + hstep, voffA);
            PG8_WAIT_V(8); PG8_WAIT_L(0); PG8_BAR; PG8_MMA(0, 0, At, B0); PG8_MMA(0, 1, At, B1); PG8_BAR; PG8_SCHED;
            PG8_LDA(At, 0, 1); PG8_STAGE(PG8_SB(0, 0), b2, voffB); PG8_STAGE(PG8_SB(0, 1), b2 + hstep, voffB); PG8_STAGE(PG8_SA(0, 0), a2, voffA);
            PG8_WAIT_V(8); PG8_WAIT_L(0); PG8_BAR; PG8_MMA(1, 0, At, B0); PG8_MMA(1, 1, At, B1); PG8_BAR; PG8_SCHED;
            PG8_LDB(B0, 1, 0); PG8_LDB(B1, 1, 1); PG8_SCHED; PG8_LDA(At, 1, 0); PG8_STAGE(PG8_SA(0, 1), a2 + hstep, voffA);
            PG8_WAIT_V(8); PG8_WAIT_L(0); PG8_BAR; PG8_MMA(0, 0, At, B0); PG8_MMA(0, 1, At, B1); PG8_BAR; PG8_SCHED;
            PG8_LDA(At, 1, 1); PG8_STAGE(PG8_SB(1, 0), b3, voffB); PG8_STAGE(PG8_SB(1, 1), b3 + hstep, voffB); PG8_STAGE(PG8_SA(1, 0), a3, voffA);
            PG8_WAIT_V(8); PG8_WAIT_L(0); PG8_BAR; PG8_MMA(1, 0, At, B0); PG8_MMA(1, 1, At, B1); PG8_BAR; PG8_SCHED;
            } else {
            PG8_LDB(B0, 0, 0); PG8_SCHED; PG8_LDA(At, 0, 0); PG8_STAGE(PG8_SA(1, 1), a1 + hstep, voffA);
            PG8_WAIT_L(8); PG8_BAR; PG8_WAIT_L(0); PG8_MMA(0, 0, At, B0); PG8_BAR; PG8_SCHED;
            PG8_LDB(B1, 0, 1); PG8_STAGE(PG8_SB(0, 0), b2, voffB);
            PG8_BAR; PG8_WAIT_L(0); PG8_MMA(0, 1, At, B1); PG8_BAR;
            PG8_LDA(At, 0, 1); PG8_STAGE(PG8_SA(0, 0), a2, voffA);
            PG8_BAR; PG8_WAIT_L(0); PG8_MMA(1, 0, At, B0); PG8_BAR; PG8_SCHED;
            PG8_STAGE(PG8_SB(0, 1), b2 + hstep, voffB);
            PG8_WAIT_V(6); PG8_BAR; PG8_MMA(1, 1, At, B1); PG8_BAR;
            PG8_LDB(B0, 1, 0); PG8_SCHED; PG8_LDA(At, 1, 0); PG8_STAGE(PG8_SA(0, 1), a2 + hstep, voffA);
            PG8_WAIT_L(8); PG8_BAR; PG8_WAIT_L(0); PG8_MMA(0, 0, At, B0); PG8_BAR; PG8_SCHED;
            PG8_LDB(B1, 1, 1); PG8_STAGE(PG8_SB(1, 0), b3, voffB);
            PG8_BAR; PG8_WAIT_L(0); PG8_MMA(0, 1, At, B1); PG8_BAR;
            PG8_LDA(At, 1, 1); PG8_STAGE(PG8_SA(1, 0), a3, voffA);
            PG8_BAR; PG8_WAIT_L(0); PG8_MMA(1, 0, At, B0); PG8_BAR; PG8_SCHED;
            PG8_STAGE(PG8_SB(1, 1), b3 + hstep, voffB);
            PG8_WAIT_V(6); PG8_BAR; PG8_MMA(1, 1, At, B1); PG8_BAR;
            }
        }
        if constexpr (ALIGN_EPI) { if (wr == 0) PG8_BAR; }
        if constexpr (!Epi::AFTER_DRAIN) { E(acc, cur, wr, wc, fr, fq); S.done(cur); }
        if (!has_next) break;
#pragma unroll
        for (int a = 0; a < 2; ++a)
#pragma unroll
            for (int b = 0; b < 2; ++b)
#pragma unroll
                for (int m = 0; m < 4; ++m)
#pragma unroll
                    for (int n = 0; n < 2; ++n) acc[a][b][m][n] = (f32x4){0.f, 0.f, 0.f, 0.f};
        cur = nxt; cA = nA; cB = nB; ++ui;
        if constexpr (ALIGN_EPI) { if (wr == 1) PG8_BAR; }
    }
    PG8_WAIT_V(0);
    if constexpr (!ALIGN_EPI) { if (wr == 0) PG8_BAR; }
    PG8_BAR;
    if constexpr (Epi::AFTER_DRAIN) { E.fused(acc, cur, wr, wc, fr, fq, lds, wid, lane); S.done(cur); }
#undef PG8_SA
#undef PG8_SB
#undef PG8_STAGE
#undef PG8_LDA
#undef PG8_LDB
#undef PG8_MMA
#undef PG8_WAIT_V
#undef PG8_WAIT_L
#undef PG8_BAR
#undef PG8_SCHED
}
}
#define LAS __attribute__((address_space(3)))
typedef unsigned short bf16;
typedef unsigned v4u __attribute__((ext_vector_type(4)));
typedef unsigned v2u __attribute__((ext_vector_type(2)));
typedef float f32x4 __attribute__((ext_vector_type(4)));
typedef float f32x16 __attribute__((ext_vector_type(16)));
typedef short bf16x8 __attribute__((ext_vector_type(8)));
typedef short s16x4 __attribute__((ext_vector_type(4)));

constexpr int NTOK = 12288, DM = 1024, DIN = 3584, NLAYER = 4;
constexpr size_t MiB = 1u << 20;
constexpr size_t WS_WIN = 0, WS_WOUT = 28 * MiB, WS_MOD = 36 * MiB, WS_H = 37 * MiB, WS_P = 61 * MiB, WS_Y = 145 * MiB, WS_X = 169 * MiB,
                 WS_VTC = 217 * MiB, WS_VTD = 220 * MiB, WS_CKC = 226 * MiB, WS_CVTC = 227 * MiB, WS_CKD = 228 * MiB, WS_CVTD = 230 * MiB, WS_END = 232 * MiB;
constexpr int LDS_BYTES = 147456;
constexpr float LOG2E = 1.4426950408889634f;
constexpr float SC2 = 0.125f * 1.4426950408889634f;

struct Params { const float* in[19]; float* out; unsigned char* ws; };

__device__ __forceinline__ float bf2f(unsigned short b) { return __uint_as_float((unsigned)b << 16); }
__device__ __forceinline__ float bflo(unsigned w) { return __uint_as_float(w << 16); }
__device__ __forceinline__ float bfhi(unsigned w) { return __uint_as_float(w & 0xffff0000u); }
__device__ __forceinline__ unsigned pk2(float lo, float hi) { return pg8::cvt_pk_bf16(lo, hi); }
__device__ __forceinline__ float silu(float v) { return v / (1.f + __expf(-v)); }
__device__ __forceinline__ float wave_sum(float v) {
#pragma unroll
    for (int o = 1; o < 64; o <<= 1) v += __shfl_xor(v, o);
    return v;
}
__device__ __forceinline__ int opq_v(int x) { asm volatile("" : "+v"(x)); return x; }
__device__ __forceinline__ int opq_s(int x) { asm volatile("" : "+s"(x)); return x; }
template <class T> __device__ __forceinline__ T* opq_p(T* x) { asm volatile("" : "+s"(x)); return x; }
#define LDS_WAIT() asm volatile("s_waitcnt lgkmcnt(0)" ::: "memory")
#define MFMA32(a, b, c) __builtin_amdgcn_mfma_f32_32x32x16_bf16((a), (b), (c), 0, 0, 0)

__device__ __forceinline__ void transpose_item(const float* W, int K, int N, bf16* WT, LAS float* scr, int item, int lane) {
    const int nblk = N / 32, kb = item / nblk, nb = item % nblk, k0 = 64 * kb, n0 = 32 * nb;
#pragma unroll 8
    for (int i = 0; i < 32; ++i) { const int kk = 2 * i + (lane >> 5); scr[kk * 33 + (lane & 31)] = ((const GAS float*)W)[(size_t)(k0 + kk) * N + n0 + (lane & 31)]; }
    LDS_WAIT(); asm volatile("" ::: "memory");
    const int c = lane & 7;
#pragma unroll
    for (int j = 0; j < 4; ++j) { const int n = (lane >> 3) + 8 * j; const LAS float* s = scr + (8 * c) * 33 + n;
        v4u o; o.x = pk2(s[0 * 33], s[1 * 33]); o.y = pk2(s[2 * 33], s[3 * 33]); o.z = pk2(s[4 * 33], s[5 * 33]); o.w = pk2(s[6 * 33], s[7 * 33]);
        *(GAS v4u*)(WT + (size_t)(n0 + n) * K + k0 + 8 * c) = o; }
    LDS_WAIT(); asm volatile("" ::: "memory");
}

__device__ __forceinline__ void prep_phase(const Params& p, LAS unsigned char* lds) {
    const int tid = threadIdx.x, lane = tid & 63, wave = tid >> 6;
    const GAS float* c_lat = (const GAS float*)p.in[6]; const GAS float* c_ctx = (const GAS float*)p.in[7]; const GAS float* w_mod = (const GAS float*)p.in[9]; const GAS float* b_mod = (const GAS float*)p.in[10];
    GAS float* MOD = (GAS float*)(p.ws + WS_MOD);
    LAS float* sc = (LAS float*)lds;
    LAS float* red = sc + 3072;
    if ((int)blockIdx.x < 192) {
        for (int i = tid; i < 3072; i += 512) { const int cnd = i >> 10, k = i & 1023; const float v = cnd == 0 ? c_ctx[k] : c_lat[(cnd - 1) * 1024 + k]; sc[i] = silu(v); }
        __syncthreads();
        for (int it = blockIdx.x; it < 192; it += gridDim.x) {
            const int l = it / 48, n0 = (it % 48) * 64;
            const GAS float* W = w_mod + (size_t)l * 1024 * 3072 + n0 + lane;
            float a0 = 0.f, a1 = 0.f, a2 = 0.f;
            const int k0 = wave * 128;
#pragma unroll 8
            for (int k = 0; k < 128; ++k) { const float w = W[(size_t)(k0 + k) * 3072]; a0 += sc[k0 + k] * w; a1 += sc[1024 + k0 + k] * w; a2 += sc[2048 + k0 + k] * w; }
            red[(wave * 3 + 0) * 64 + lane] = a0; red[(wave * 3 + 1) * 64 + lane] = a1; red[(wave * 3 + 2) * 64 + lane] = a2;
            __syncthreads();
            if (tid < 192) { const int cnd = tid >> 6; float s = b_mod[l * 3072 + n0 + lane];
#pragma unroll
                for (int w = 0; w < 8; ++w) s += red[(w * 3 + cnd) * 64 + lane];
                MOD[(l * 3 + cnd) * 3072 + n0 + lane] = s; }
            __syncthreads();
        }
    }
    {
        LAS float* scr = (LAS float*)(lds + 20480 + wave * 8448);
        const int gw = blockIdx.x * 8 + wave, NGW = gridDim.x * 8;
        bf16* WinT = (bf16*)(p.ws + WS_WIN); bf16* WoutT = (bf16*)(p.ws + WS_WOUT);
        constexpr int I_IN = 16 * 112, I_OUT = 16 * 32, NITEMS = NLAYER * (I_IN + I_OUT);
        const bool balT = gridDim.x == 256;
        const int bx_ = blockIdx.x;
        const int first_ = balT ? (bx_ < 192 ? gw * 4 : 6144 + (gw - 1536) * 6) : gw, cnt_ = balT ? (bx_ < 192 ? 4 : 6) : (NITEMS - gw + NGW - 1) / NGW, step_ = balT ? 1 : NGW;
        for (int k_ = 0; k_ < cnt_; ++k_) {
            const int it = first_ + k_ * step_;
            const int l = it / (I_IN + I_OUT), r = it % (I_IN + I_OUT);
            if (r < I_IN) transpose_item(p.in[11] + (size_t)l * DM * DIN, DM, DIN, WinT + (size_t)l * DIN * DM, scr, r, lane);
            else transpose_item(p.in[12] + (size_t)l * DM * DM, DM, DM, WoutT + (size_t)l * DM * DM, scr, r - I_IN, lane);
        }
    }
    {
        const int gt = blockIdx.x * 512 + tid, NGT = gridDim.x * 512;
        for (int pass = 0; pass < 2; ++pass) {
            const int Hh = pass == 0 ? 2 : 4;
            const float* ck = p.in[pass == 0 ? 2 : 4]; const float* cv = p.in[pass == 0 ? 3 : 5];
            bf16* KO = (bf16*)(p.ws + (pass == 0 ? WS_CKC : WS_CKD)); bf16* VO = (bf16*)(p.ws + (pass == 0 ? WS_CVTC : WS_CVTD));
            const int nk = 8 * 512 * Hh * 8;
            for (int i = gt; i < nk; i += NGT) {
                const int d8 = i & 7, h = (i >> 3) % Hh, key = ((i >> 3) / Hh) & 511, bl = ((i >> 3) / Hh) >> 9;
                const float* s = ck + ((size_t)(bl * 512 + key) * Hh + h) * 64 + d8 * 8;
                const f32x4 a = *(const GAS f32x4*)s, b = *(const GAS f32x4*)(s + 4);
                v4u o; o.x = pk2(a[0], a[1]); o.y = pk2(a[2], a[3]); o.z = pk2(b[0], b[1]); o.w = pk2(b[2], b[3]);
                *(GAS v4u*)(KO + ((size_t)(bl * Hh + h) * 512 + key) * 64 + d8 * 8) = o;
            }
            const int nv = 8 * Hh * 64 * 64;
            for (int i = gt; i < nv; i += NGT) {
                const int d = i & 63, k8 = (i >> 6) & 63, h = (i >> 12) % Hh, bl = (i >> 12) / Hh;
                const GAS float* s = (const GAS float*)(cv + ((size_t)(bl * 512 + k8 * 8) * Hh + h) * 64 + d);
                float v[8];
#pragma unroll
                for (int e = 0; e < 8; ++e) v[e] = s[(size_t)e * Hh * 64];
                v4u o; o.x = pk2(v[0], v[1]); o.y = pk2(v[2], v[3]); o.z = pk2(v[4], v[5]); o.w = pk2(v[6], v[7]);
                *(GAS v4u*)(VO + ((size_t)(bl * Hh + h) * 64 + d) * 512 + k8 * 8) = o;
            }
        }
    }
}

template <bool FINAL>
__device__ __forceinline__ void norm_phase(const float* xc, const float* xl, const float* g, const float* mod, bf16* H, float* out) {
    const int tid_ = opq_v(threadIdx.x), bid_ = opq_s(blockIdx.x);
    const int lane = tid_ & 63, gw = bid_ * 8 + (tid_ >> 6), NGW = gridDim.x * 8;
    for (int row = gw; row < NTOK; row += NGW) {
        const float* xr = row < 4096 ? xc + (size_t)row * DM : xl + (size_t)(row - 4096) * DM;
        const int cond = row < 4096 ? 0 : 1 + ((row - 4096) >> 12);
        f32x4 v[4]; float s = 0.f;
#pragma unroll
        for (int j = 0; j < 4; ++j) { v[j] = *(const GAS f32x4*)(xr + 4 * (lane + 64 * j)); s += (v[j][0] * v[j][0] + v[j][1] * v[j][1]) + (v[j][2] * v[j][2] + v[j][3] * v[j][3]); }
        s = wave_sum(s);
        const float rstd = rsqrtf(s * (1.f / DM) + 1e-6f);
#pragma unroll
        for (int j = 0; j < 4; ++j) {
            const int col = 4 * (lane + 64 * j);
            const f32x4 gg = *(const GAS f32x4*)(g + col);
            f32x4 y = v[j] * rstd * gg;
            if (FINAL) { *(GAS f32x4*)(out + (size_t)row * DM + col) = y; }
            else {
                const f32x4 sh = *(const GAS f32x4*)(mod + cond * 3072 + col), scl = *(const GAS f32x4*)(mod + cond * 3072 + 1024 + col);
                y = y * (1.f + scl) + sh;
                v2u o; o.x = pk2(y[0], y[1]); o.y = pk2(y[2], y[3]);
                *(GAS v2u*)(H + (size_t)row * DM + col) = o;
            }
        }
    }
}

struct MaskNone { __device__ __forceinline__ float operator()(float s, int) const { return s * SC2; } };
struct MaskWin { int k0, qpos;
    __device__ __forceinline__ float operator()(float s, int kr) const { const int d = k0 + kr - qpos; return (d <= 128 && d >= -128) ? s * SC2 : -1e30f; } };
struct MaskNb { int kc0, qc, cs; const LAS float* rp;
    __device__ __forceinline__ float operator()(float s, int kr) const { const int kc = kc0 + kr; const bool ok = kc >= cs && kc < cs + 16; const int bi = ok ? kc - qc + 15 : 0; const float bv = rp[bi]; return ok ? s * SC2 + bv : -1e30f; } };

template <class MF>
__device__ __forceinline__ void attn_block(const bf16* krow, const bf16* vt, int vts, const bf16x8 (&qf)[4], f32x16& o0, f32x16& o1, float& m, float& l, const MF& mf, int hh) {
    bf16x8 kf[4];
#pragma unroll
    for (int ks = 0; ks < 4; ++ks) kf[ks] = *(const GAS bf16x8*)(krow + ks * 16 + hh * 8);
    s16x4 va[2][2][2];
#pragma unroll
    for (int dt = 0; dt < 2; ++dt)
#pragma unroll
        for (int s2 = 0; s2 < 2; ++s2) {
            const bf16* vp = vt + (size_t)dt * 32 * vts + 16 * s2 + 4 * hh;
            va[dt][s2][0] = *(const GAS s16x4*)vp; va[dt][s2][1] = *(const GAS s16x4*)(vp + 8);
        }
    f32x16 s;
#pragma unroll
    for (int i = 0; i < 16; ++i) s[i] = 0.f;
#pragma unroll
    for (int ks = 0; ks < 4; ++ks) s = MFMA32(kf[ks], qf[ks], s);
    float mx = -3e38f;
#pragma unroll
    for (int i = 0; i < 16; ++i) { const float t = mf(s[i], (i & 3) + 8 * (i >> 2) + 4 * hh); s[i] = t; mx = fmaxf(mx, t); }
    mx = fmaxf(mx, __shfl_xor(mx, 32));
    const float mn = fmaxf(m, mx);
    const float alpha = __builtin_amdgcn_exp2f(m - mn);
    float rs = 0.f;
#pragma unroll
    for (int i = 0; i < 16; ++i) { s[i] = __builtin_amdgcn_exp2f(s[i] - mn); rs += s[i]; }
    rs += __shfl_xor(rs, 32);
    l = l * alpha + rs; m = mn;
#pragma unroll
    for (int i = 0; i < 16; ++i) { o0[i] *= alpha; o1[i] *= alpha; }
#pragma unroll
    for (int s2 = 0; s2 < 2; ++s2) {
        v4u pw; pw.x = pk2(s[8 * s2 + 0], s[8 * s2 + 1]); pw.y = pk2(s[8 * s2 + 2], s[8 * s2 + 3]); pw.z = pk2(s[8 * s2 + 4], s[8 * s2 + 5]); pw.w = pk2(s[8 * s2 + 6], s[8 * s2 + 7]);
        const bf16x8 pb = __builtin_bit_cast(bf16x8, pw);
        const bf16x8 a0 = __builtin_shufflevector(va[0][s2][0], va[0][s2][1], 0, 1, 2, 3, 4, 5, 6, 7);
        const bf16x8 a1 = __builtin_shufflevector(va[1][s2][0], va[1][s2][1], 0, 1, 2, 3, 4, 5, 6, 7);
        o0 = MFMA32(a0, pb, o0);
        o1 = MFMA32(a1, pb, o1);
    }
}
__device__ __forceinline__ void attn_block_lds(const LAS bf16* Kt, const LAS bf16* Vt, const bf16x8 (&qf)[4], f32x16& o0, f32x16& o1, float& m, float& l,
                                               int xbase, int lo, int hi, const LAS float* rp, int boff, int hh, int l31, int vs = 72) {
    const int krow = (l31 & 19) | ((l31 & 4) << 1) | ((l31 & 8) >> 1);
    bf16x8 kf[4];
#pragma unroll
    for (int ks = 0; ks < 4; ++ks) kf[ks] = *(const LAS bf16x8*)(Kt + krow * 72 + ks * 16 + hh * 8);
    bf16x8 vf[2][2];
#pragma unroll
    for (int dt = 0; dt < 2; ++dt)
#pragma unroll
        for (int s2 = 0; s2 < 2; ++s2) vf[dt][s2] = *(const LAS bf16x8*)(Vt + (dt * 32 + l31) * vs + 16 * s2 + 8 * hh);
    f32x16 s;
#pragma unroll
    for (int i = 0; i < 16; ++i) s[i] = 0.f;
#pragma unroll
    for (int ks = 0; ks < 4; ++ks) s = MFMA32(kf[ks], qf[ks], s);
    float mx = -3e38f;
    if (rp != nullptr) {
#pragma unroll
        for (int i = 0; i < 16; ++i) { const int x = xbase + (i & 3) + 4 * ((i >> 2) & 1) + 8 * hh + 16 * (i >> 3); const bool ok = x >= lo && x <= hi;
            const float bv = rp[ok ? x + boff : 0]; const float t = ok ? s[i] * SC2 + bv : -1e30f; s[i] = t; mx = fmaxf(mx, t); }
    } else {
#pragma unroll
        for (int i = 0; i < 16; ++i) { const int x = xbase + (i & 3) + 4 * ((i >> 2) & 1) + 8 * hh + 16 * (i >> 3); const bool ok = x >= lo && x <= hi;
            const float t = ok ? s[i] * SC2 : -1e30f; s[i] = t; mx = fmaxf(mx, t); }
    }
    mx = fmaxf(mx, __shfl_xor(mx, 32));
    const float mn = fmaxf(m, mx);
    const float alpha = __builtin_amdgcn_exp2f(m - mn);
    float rs = 0.f;
#pragma unroll
    for (int i = 0; i < 16; ++i) { s[i] = __builtin_amdgcn_exp2f(s[i] - mn); rs += s[i]; }
    rs += __shfl_xor(rs, 32);
    l = l * alpha + rs; m = mn;
#pragma unroll
    for (int i = 0; i < 16; ++i) { o0[i] *= alpha; o1[i] *= alpha; }
#pragma unroll
    for (int s2 = 0; s2 < 2; ++s2) {
        v4u pw; pw.x = pk2(s[8 * s2 + 0], s[8 * s2 + 1]); pw.y = pk2(s[8 * s2 + 2], s[8 * s2 + 3]); pw.z = pk2(s[8 * s2 + 4], s[8 * s2 + 5]); pw.w = pk2(s[8 * s2 + 6], s[8 * s2 + 7]);
        const bf16x8 pb = __builtin_bit_cast(bf16x8, pw);
        o0 = MFMA32(vf[0][s2], pb, o0);
        o1 = MFMA32(vf[1][s2], pb, o1);
    }
}
__device__ __forceinline__ void attn_store(const f32x16& o0, const f32x16& o1, float l, const bf16* zrow, bf16* yrow, int hh) {
    const float inv = 1.f / l;
#pragma unroll
    for (int dt = 0; dt < 2; ++dt)
#pragma unroll
        for (int g = 0; g < 4; ++g) {
            const int d = dt * 32 + 8 * g + 4 * hh;
            const v2u zz = *(const GAS v2u*)(zrow + d);
            float y[4];
#pragma unroll
            for (int e = 0; e < 4; ++e) { const float ov = (dt == 0 ? o0[4 * g + e] : o1[4 * g + e]) * inv; const float z = (e & 1) ? bfhi(e < 2 ? zz.x : zz.y) : bflo(e < 2 ? zz.x : zz.y); y[e] = ov * silu(z); }
            v2u w; w.x = pk2(y[0], y[1]); w.y = pk2(y[2], y[3]);
            *(GAS v2u*)(yrow + d) = w;
        }
}
__device__ __forceinline__ void load_q(bf16x8 (&qf)[4], const bf16* qrow, int hh) {
#pragma unroll
    for (int ks = 0; ks < 4; ++ks) qf[ks] = *(const GAS bf16x8*)(qrow + ks * 16 + hh * 8);
}

__device__ __forceinline__ void mixer_phase(const Params& p, int layer, LAS unsigned char* lds) {
    const int tid = opq_v(threadIdx.x), lane = tid & 63, wave = tid >> 6, hh = lane >> 5, l31 = lane & 31;
    const int bid = opq_s(bid);
    unsigned char* ws = opq_p(p.ws);
    const bf16* P = (const bf16*)(ws + WS_P); bf16* Y = (bf16*)(ws + WS_Y);
    const bf16* VTC = (const bf16*)(ws + WS_VTC); const bf16* VTD = (const bf16*)(ws + WS_VTD);
    const bf16* CKC = (const bf16*)(ws + WS_CKC); const bf16* CVTC = (const bf16*)(ws + WS_CVTC);
    const bf16* CKD = (const bf16*)(ws + WS_CKD); const bf16* CVTD = (const bf16*)(ws + WS_CVTD);
    LAS float* rpb_s = (LAS float*)lds;
    LAS bf16* vT = (LAS bf16*)(lds + 8192);
    { const GAS float* rpb = (const GAS float*)(opq_p(p.in[17]) + layer * 1860); for (int i = tid; i < 1860; i += 512) rpb_s[i] = rpb[i] * LOG2E; }
    __syncthreads();

    {
        const float* w_s = opq_p(p.in[13]) + (size_t)layer * 4 * 128 * 128; const GAS float* b_s = (const GAS float*)(opq_p(p.in[14]) + layer * 4 * 128);
        const bool balA = gridDim.x == 256;
        const int nA = balA ? (bid < 128 ? 3 : 0) : (384 - bid + (int)gridDim.x - 1) / (int)gridDim.x;
        for (int kA = 0; kA < nA; ++kA) {
            const int it = balA ? bid * 3 + kA : bid + kA * (int)gridDim.x;
            const int n = it >> 2, h = it & 3, row0 = n * 128;
            {
                const int q = tid >> 2, dq = (tid & 3) * 16;
                const bf16* src = P + (size_t)(row0 + q) * DIN + 256 + h * 64 + dq;
                const v4u a = *(const GAS v4u*)src, b = *(const GAS v4u*)(src + 8);
                float v[16];
                v[0] = bflo(a.x); v[1] = bfhi(a.x); v[2] = bflo(a.y); v[3] = bfhi(a.y); v[4] = bflo(a.z); v[5] = bfhi(a.z); v[6] = bflo(a.w); v[7] = bfhi(a.w);
                v[8] = bflo(b.x); v[9] = bfhi(b.x); v[10] = bflo(b.y); v[11] = bfhi(b.y); v[12] = bflo(b.z); v[13] = bfhi(b.z); v[14] = bflo(b.w); v[15] = bfhi(b.w);
                float ss = 0.f;
#pragma unroll
                for (int e = 0; e < 16; ++e) ss += v[e] * v[e];
                ss += __shfl_xor(ss, 1); ss += __shfl_xor(ss, 2);
                const float scl = rsqrtf(ss * (1.f / 64.f) + 1e-6f);
#pragma unroll
                for (int e = 0; e < 16; e += 2) { const unsigned w = pk2(v[e] * scl, v[e + 1] * scl); vT[(dq + e) * 136 + q] = (bf16)(w & 0xffff); vT[(dq + e + 1) * 136 + q] = (bf16)(w >> 16); }
            }
            __syncthreads();
            const int dt = wave & 1, pt = wave >> 1;
            f32x16 acc;
#pragma unroll
            for (int i = 0; i < 16; ++i) acc[i] = 0.f;
            const float* wrow = w_s + ((size_t)h * 128 + pt * 32 + l31) * 128 + hh * 8;
#pragma unroll
            for (int ks = 0; ks < 8; ++ks) {
                const bf16x8 A = *(const LAS bf16x8*)(vT + (dt * 32 + l31) * 136 + ks * 16 + hh * 8);
                const f32x4 w0 = *(const GAS f32x4*)(wrow + ks * 16), w1 = *(const GAS f32x4*)(wrow + ks * 16 + 4);
                v4u bw; bw.x = pk2(w0[0], w0[1]); bw.y = pk2(w0[2], w0[3]); bw.z = pk2(w1[0], w1[1]); bw.w = pk2(w1[2], w1[3]);
                acc = MFMA32(A, __builtin_bit_cast(bf16x8, bw), acc);
            }
            const int pp = pt * 32 + l31, row = row0 + pp;
            const float bias = b_s[h * 128 + pp];
#pragma unroll
            for (int g = 0; g < 4; ++g) {
                const int d = dt * 32 + 8 * g + 4 * hh;
                const v2u uu = *(const GAS v2u*)(P + (size_t)row * DIN + h * 64 + d), zz = *(const GAS v2u*)(P + (size_t)row * DIN + 512 + h * 64 + d);
                const float y0 = bflo(uu.x) * (acc[4 * g + 0] + bias) * silu(bflo(zz.x)), y1 = bfhi(uu.x) * (acc[4 * g + 1] + bias) * silu(bfhi(zz.x));
                const float y2 = bflo(uu.y) * (acc[4 * g + 2] + bias) * silu(bflo(zz.y)), y3 = bfhi(uu.y) * (acc[4 * g + 3] + bias) * silu(bfhi(zz.y));
                v2u w; w.x = pk2(y0, y1); w.y = pk2(y2, y3);
                *(GAS v2u*)(Y + (size_t)row * DM + h * 64 + d) = w;
            }
            __syncthreads();
        }
    }
    {
        const GAS float* wc = (const GAS float*)(opq_p(p.in[15]) + layer * 768);
        const bool balB = gridDim.x == 256;
        const int gt = bid * 512 + tid, NGT = balB ? 128 * 512 : (int)gridDim.x * 512;
        for (int idx = (balB && bid >= 128) ? NTOK * 32 : gt; idx < NTOK * 32; idx += NGT) {
            const int row = idx >> 5, c8 = (idx & 31) * 8;
            const int t = row < 4096 ? (row & 255) : ((row - 4096) & 4095), L = row < 4096 ? 256 : 4096;
            const bf16* pr = P + (size_t)row * DIN;
            const v4u bb = *(const GAS v4u*)(pr + 768 + c8), zz = *(const GAS v4u*)(pr + 1536 + c8);
            const v4u c1 = *(const GAS v4u*)(pr + 1024 + c8), h1 = *(const GAS v4u*)(pr + 1280 + c8);
            v4u c0 = {0u, 0u, 0u, 0u}, h0 = c0, c2 = c0, h2 = c0;
            if (t > 0) { c0 = *(const GAS v4u*)(pr - DIN + 1024 + c8); h0 = *(const GAS v4u*)(pr - DIN + 1280 + c8); }
            if (t < L - 1) { c2 = *(const GAS v4u*)(pr + DIN + 1024 + c8); h2 = *(const GAS v4u*)(pr + DIN + 1280 + c8); }
            unsigned ow[4];
#pragma unroll
            for (int e = 0; e < 4; ++e) {
                const unsigned wb = e == 0 ? bb.x : e == 1 ? bb.y : e == 2 ? bb.z : bb.w, wz = e == 0 ? zz.x : e == 1 ? zz.y : e == 2 ? zz.z : zz.w;
                const unsigned wc0 = e == 0 ? c0.x : e == 1 ? c0.y : e == 2 ? c0.z : c0.w, wh0 = e == 0 ? h0.x : e == 1 ? h0.y : e == 2 ? h0.z : h0.w;
                const unsigned wc1 = e == 0 ? c1.x : e == 1 ? c1.y : e == 2 ? c1.z : c1.w, wh1 = e == 0 ? h1.x : e == 1 ? h1.y : e == 2 ? h1.z : h1.w;
                const unsigned wc2 = e == 0 ? c2.x : e == 1 ? c2.y : e == 2 ? c2.z : c2.w, wh2 = e == 0 ? h2.x : e == 1 ? h2.y : e == 2 ? h2.z : h2.w;
                const int ch = c8 + 2 * e;
                const float ylo = bflo(wb) * (wc[ch] * (bflo(wc0) * bflo(wh0)) + wc[256 + ch] * (bflo(wc1) * bflo(wh1)) + wc[512 + ch] * (bflo(wc2) * bflo(wh2))) * silu(bflo(wz));
                const float yhi = bfhi(wb) * (wc[ch + 1] * (bfhi(wc0) * bfhi(wh0)) + wc[256 + ch + 1] * (bfhi(wc1) * bfhi(wh1)) + wc[512 + ch + 1] * (bfhi(wc2) * bfhi(wh2))) * silu(bfhi(wz));
                ow[e] = pk2(ylo, yhi);
            }
            v4u o; o.x = ow[0]; o.y = ow[1]; o.z = ow[2]; o.w = ow[3];
            *(GAS v4u*)(Y + (size_t)row * DM + 256 + c8) = o;
        }
    }
    const bool ctx_lds = gridDim.x == 256;
    if (ctx_lds && bid < 128) {
        const int it = bid, h8 = it & 7, b = it >> 3, h = h8 & 3; const bool isC = h8 < 4;
        const int row0 = b * 256, qrow = row0 + wave * 32 + l31;
        LAS bf16* const Kb = (LAS bf16*)(lds + 32768);
        LAS bf16* const Vb = Kb + 256 * 72;
        const int kcol = isC ? 2048 + (h >> 1) * 64 : 2816 + h * 64;
        const bf16* const vt0 = isC ? VTC + ((size_t)((b * 2 + (h >> 1)) * 64)) * 256 : VTD + ((size_t)((b * 4 + h) * 64)) * 256;
#pragma unroll
        for (int j = 0; j < 4; ++j) {
            const int c = tid + 512 * j;
            const v4u kv = *(const GAS v4u*)(P + (size_t)(row0 + (c >> 3)) * DIN + kcol + (c & 7) * 8);
            const v4u vv = *(const GAS v4u*)(vt0 + (size_t)(c >> 5) * 256 + (c & 31) * 8);
            *(LAS v4u*)(Kb + (c >> 3) * 72 + (c & 7) * 8) = kv;
            *(LAS v4u*)(Vb + (c >> 5) * 264 + (c & 31) * 8) = vv;
        }
        bf16x8 qf[4];
        load_q(qf, P + (size_t)qrow * DIN + (isC ? 1792 : 2560) + h * 64, hh);
        f32x16 o0, o1;
#pragma unroll
        for (int i = 0; i < 16; ++i) { o0[i] = 0.f; o1[i] = 0.f; }
        const GAS float* sinkp0 = (const GAS float*)(opq_p(p.in[16]) + layer * 4);
        float m = isC ? sinkp0[h] * LOG2E : -1e30f, l = isC ? 1.f : 0.f;
        __syncthreads();
#pragma unroll 1
        for (int kb = 0; kb < 8; ++kb)
            attn_block_lds(Kb + kb * 32 * 72, Vb + kb * 32, qf, o0, o1, m, l, 0, -(1 << 30), 1 << 30, nullptr, 0, hh, l31, 264);
        attn_store(o0, o1, l, P + (size_t)qrow * DIN + (isC ? 2304 : 3328) + h * 64, Y + (size_t)qrow * DM + (isC ? 512 : 768) + h * 64, hh);
        __syncthreads();
    }
    const int gw = bid * 8 + wave, NGW = gridDim.x * 8;
    const GAS float* sinkp = (const GAS float*)(opq_p(p.in[16]) + layer * 4);
    for (int it = gw; it < 2048; it += NGW) {
        f32x16 o0, o1;
#pragma unroll
        for (int i = 0; i < 16; ++i) { o0[i] = 0.f; o1[i] = 0.f; }
        bf16x8 qf[4];
        if (it < 1024) {
            const int jlo = it & 7, g = (it >> 3) & 1, jhi = (it >> 4) & 15, kvh = (it >> 8) & 1, b = it >> 9;
            const int hq = kvh * 2 + g, j = jhi * 8 + jlo, qpos0 = j * 32, rowbase = 4096 + b * 4096, qrow = rowbase + qpos0 + l31;
            load_q(qf, P + (size_t)qrow * DIN + 1792 + hq * 64, hh);
            float m = sinkp[hq] * LOG2E, l = 1.f;
            const size_t cb = (size_t)((b * 4 + layer) * 2 + kvh);
            for (int kb = 0; kb < 16; ++kb)
                attn_block(CKC + (cb * 512 + kb * 32 + l31) * 64, CVTC + (cb * 64 + l31) * 512 + kb * 32, 512, qf, o0, o1, m, l, MaskNone(), hh);
            for (int i = 0; i < 9; ++i) {
                const int k0 = qpos0 - 128 + 32 * i;
                if (k0 < 0 || k0 >= 4096) continue;
                MaskWin mw; mw.k0 = k0; mw.qpos = qpos0 + l31;
                attn_block(P + (size_t)(rowbase + k0 + l31) * DIN + 2048 + kvh * 64, VTC + pg8::VTC_LAT + ((size_t)((b * 2 + kvh) * 64 + l31)) * 4096 + k0, 4096, qf, o0, o1, m, l, mw, hh);
            }
            attn_store(o0, o1, l, P + (size_t)qrow * DIN + 2304 + hq * 64, Y + (size_t)qrow * DM + 512 + hq * 64, hh);
        } else {
            const int i2 = it - 1024, ch = i2 & 1, r = (i2 >> 1) & 63, h = (i2 >> 7) & 3, b = i2 >> 9;
            const int qc = ch * 32 + l31, rowbase = 4096 + b * 4096, qrow = rowbase + r * 64 + qc;
            load_q(qf, P + (size_t)qrow * DIN + 2560 + h * 64, hh);
            float m = -1e30f, l = 0.f;
            const size_t cb = (size_t)((b * 4 + layer) * 4 + h);
            for (int kb = 0; kb < 16; ++kb)
                attn_block(CKD + (cb * 512 + kb * 32 + l31) * 64, CVTD + (cb * 64 + l31) * 512 + kb * 32, 512, qf, o0, o1, m, l, MaskNone(), hh);
            const int rs = min(max(r - 4, 0), 56);
            const int cs = min(max(qc - 8, 0), 48);
            for (int i = 0; i < 16; ++i) {
                const int kr = rs + (i >> 1), kc0 = (i & 1) * 32, t0 = kr * 64 + kc0;
                MaskNb mb; mb.kc0 = kc0; mb.qc = qc; mb.cs = cs; mb.rp = rpb_s + h * 465 + (kr - r + 7) * 31;
                attn_block(P + (size_t)(rowbase + t0 + l31) * DIN + 2816 + h * 64, VTD + pg8::VTD_LAT + ((size_t)((b * 4 + h) * 64 + l31)) * 4096 + t0, 4096, qf, o0, o1, m, l, mb, hh);
            }
            attn_store(o0, o1, l, P + (size_t)qrow * DIN + 3328 + h * 64, Y + (size_t)qrow * DM + 768 + h * 64, hh);
        }
    }
    if (!ctx_lds)
    for (int it = gw; it < 1024; it += NGW) {
        const int qb = it & 7, h8 = (it >> 3) & 7, b = it >> 6;
        const bool isC = h8 < 4; const int h = h8 & 3;
        const int row0 = b * 256, qrow = row0 + qb * 32 + l31;
        f32x16 o0, o1;
#pragma unroll
        for (int i = 0; i < 16; ++i) { o0[i] = 0.f; o1[i] = 0.f; }
        bf16x8 qf[4];
        load_q(qf, P + (size_t)qrow * DIN + (isC ? 1792 : 2560) + h * 64, hh);
        float m = isC ? sinkp[h] * LOG2E : -1e30f, l = isC ? 1.f : 0.f;
        const int kcol = isC ? 2048 + (h >> 1) * 64 : 2816 + h * 64;
        const bf16* vtb = isC ? VTC + ((size_t)((b * 2 + (h >> 1)) * 64 + l31)) * 256 : VTD + ((size_t)((b * 4 + h) * 64 + l31)) * 256;
        for (int kb = 0; kb < 8; ++kb)
            attn_block(P + (size_t)(row0 + kb * 32 + l31) * DIN + kcol, vtb + kb * 32, 256, qf, o0, o1, m, l, MaskNone(), hh);
        attn_store(o0, o1, l, P + (size_t)qrow * DIN + (isC ? 2304 : 3328) + h * 64, Y + (size_t)qrow * DM + (isC ? 512 : 768) + h * 64, hh);
    }
}

#define GRID_SYNC() do { asm volatile("s_waitcnt vmcnt(0) lgkmcnt(0)" ::: "memory"); grid.sync(); if (threadIdx.x < 64) asm volatile("buffer_inv sc1\n\ts_waitcnt vmcnt(0)" ::: "memory"); __syncthreads(); } while (0)
__global__ void __launch_bounds__(512, 2) hybrid_fwd(Params p) {
    extern __shared__ __attribute__((aligned(16))) unsigned char lds_raw[];
    LAS unsigned char* lds = (LAS unsigned char*)lds_raw;
    cg::grid_group grid = cg::this_grid();

    prep_phase(p, lds);
    GRID_SYNC();
#pragma unroll 1
    for (int layer = 0; layer < NLAYER; ++layer) {
        unsigned char* ws = opq_p(p.ws);
        float* MOD = (float*)(ws + WS_MOD);
        bf16* H = (bf16*)(ws + WS_H); bf16* P = (bf16*)(ws + WS_P); bf16* Y = (bf16*)(ws + WS_Y); float* X = (float*)(ws + WS_X);
        bf16* WinT = (bf16*)(ws + WS_WIN); bf16* WoutT = (bf16*)(ws + WS_WOUT);
        const float* xc = layer == 0 ? opq_p(p.in[0]) : X;
        const float* xl = layer == 0 ? opq_p(p.in[1]) : X + (size_t)4096 * DM;
        norm_phase<false>(xc, xl, opq_p(p.in[8]) + layer * DM, MOD + layer * 9216, H, nullptr);
        GRID_SYNC();
        {
            pg8::Gemm g{H, WinT + (size_t)layer * DIN * DM, NTOK, DIN, DM}; pg8::StaticOrder S; S.init(NTOK, DIN, (int)gridDim.x, opq_s(blockIdx.x));
            pg8::EpiProj E{P, opq_p(p.out), (bf16*)(ws + WS_VTC), (bf16*)(ws + WS_VTD), layer};
            pg8::gemm_phase<pg8::EpiProj, pg8::StaticOrder, true, true>(lds, g, S, E);
        }
        GRID_SYNC();
        mixer_phase(p, layer, lds);
        GRID_SYNC();
        {
            pg8::Gemm g{Y, WoutT + (size_t)layer * DM * DM, NTOK, DM, DM}; pg8::StaticOrder S; S.init(NTOK, DM, (int)gridDim.x, opq_s(blockIdx.x));
            pg8::EpiOut E{xc, X, MOD + layer * 9216 + 2048, xl};
            pg8::gemm_phase<pg8::EpiOut, pg8::StaticOrder, true, true>(lds, g, S, E);
        }
        GRID_SYNC();
    }
    { float* X = (float*)(p.ws + WS_X); norm_phase<true>(X, X + (size_t)4096 * DM, p.in[18], nullptr, nullptr, p.out); }
}

extern "C" void kernel_launch(void* const* d_in, const int* in_sizes, int n_in, void* d_out, int out_size, void* d_ws, size_t ws_size, hipStream_t stream) {
    static int grid = 0;
    if (grid == 0) {
        if (n_in != 19 || ws_size < WS_END) { fprintf(stderr, "kernel_launch: unexpected inputs (n_in %d, ws %zu)\n", n_in, ws_size); grid = -1; return; }
        int dev = 0, cus = 0, per_cu = 0;
        hipGetDevice(&dev);
        hipDeviceGetAttribute(&cus, hipDeviceAttributeMultiprocessorCount, dev);
        if (hipFuncSetAttribute((const void*)hybrid_fwd, hipFuncAttributeMaxDynamicSharedMemorySize, LDS_BYTES) != hipSuccess) { fprintf(stderr, "kernel_launch: hipFuncSetAttribute failed\n"); grid = -1; return; }
        if (hipOccupancyMaxActiveBlocksPerMultiprocessor(&per_cu, (const void*)hybrid_fwd, 512, LDS_BYTES) != hipSuccess || per_cu < 1) { fprintf(stderr, "kernel_launch: occupancy query says %d\n", per_cu); per_cu = 1; (void)hipGetLastError(); }
        if (per_cu > 1) per_cu = 1;
        grid = cus * per_cu;
    }
    if (grid < 0) return;
    Params p{};
    for (int i = 0; i < 19; ++i) p.in[i] = (const float*)d_in[i];
    p.out = (float*)d_out; p.ws = (unsigned char*)d_ws;
    void* args[] = {&p};
    hipError_t e = hipLaunchCooperativeKernel((const void*)hybrid_fwd, dim3(grid), dim3(512), args, LDS_BYTES, stream);
    if (e != hipSuccess) fprintf(stderr, "cooperative launch failed: %s (grid %d)\n", hipGetErrorString(e), grid);
}
```

```cpp
#include <hip/hip_runtime.h>
#include <hip/hip_cooperative_groups.h>
#include <cstdio>
#include <cstdint>
namespace cg = cooperative_groups;
namespace pg8 {
#define PG8_LAS __attribute__((address_space(3)))
#define GAS __attribute__((address_space(1)))
typedef unsigned short bf16_t;
typedef short bf16x8 __attribute__((ext_vector_type(8)));
typedef float f32x4 __attribute__((ext_vector_type(4)));
typedef unsigned u32x4 __attribute__((ext_vector_type(4)));
constexpr int BM = 256, BK = 64, HALF = 128, HTB = HALF * BK * 2  , STAGE_BYTES = 8 * HTB, NXCD = 8, WGM = 8;

__host__ __device__ __forceinline__ int lds_byte(int r, int c) { const int st = (r >> 4) * 2 + (c >> 5), rr = r & 15, cc = c & 31, ob = rr * 64 + cc * 2; return st * 1024 + (ob ^ (((ob >> 9) & 1) << 5)); }
__host__ __device__ __forceinline__ void stage_rc(int b, int& R, int& C) { const int st = b / 1024, sb = b % 1024, swz = sb ^ (((sb >> 9) & 1) << 5); R = (st >> 1) * 16 + swz / 64; C = (st & 1) * 32 + (swz % 64) / 2; }
__host__ __device__ __forceinline__ int perm32(int rho) { const int n = rho >> 4, i = rho & 15; return 8 * (i >> 2) + 4 * n + (i & 3); }

struct Unit { int pm, pn; };
struct Gemm { const bf16_t* A; const bf16_t* Bt; int M, N, K; };

struct StaticOrder {
    int nM, nN, nwg, G, c;
    __host__ __device__ void init(int M, int N, int G_, int c_) { nM = M / BM; nN = N / BM; nwg = nM * nN; G = G_; c = c_; }
    __host__ __device__ bool next(int i, Unit& u) const {
        const long L = (long)i * G + c; if (L >= nwg) return false;
        int wgid = (int)L; { const int q = nwg / NXCD, r = nwg % NXCD, xcd = wgid % NXCD, off = wgid / NXCD; wgid = (xcd < r ? xcd * (q + 1) : r * (q + 1) + (xcd - r) * q) + off; }
        const int nig = WGM * nN, gid = wgid / nig, fm = gid * WGM, gsz = (nM - fm) < WGM ? (nM - fm) : WGM;
        u.pm = fm + ((wgid % nig) % gsz); u.pn = (wgid % nig) / gsz; return true;
    }
    __device__ __forceinline__ void a_ready(const Unit&) const {}
    __device__ __forceinline__ void done(const Unit&) const {}
};
typedef float f32x2cv __attribute__((ext_vector_type(2)));
typedef __bf16 bf16x2cv __attribute__((ext_vector_type(2)));
__device__ __forceinline__ unsigned cvt_pk_bf16(float lo, float hi) { const f32x2cv v = {lo, hi}; const bf16x2cv b = __builtin_convertvector(v, bf16x2cv); return __builtin_bit_cast(unsigned, b); }
constexpr int PROJ_N = 3584;
constexpr size_t OUT_CK = 12582912, OUT_CV = 14680064, OUT_DK = 16777216, OUT_DV = 20971520;
constexpr size_t VTC_LAT = 524288, VTD_LAT = 1048576;

struct EpiProj {
    static constexpr bool PERM = true, AFTER_DRAIN = false;
    bf16_t* P; float* out; bf16_t* VTC; bf16_t* VTD; int layer;
    __device__ __forceinline__ void operator()(const f32x4 (&acc)[2][2][4][2], const Unit& u, int wr, int wc, int fr, int fq) const {
        const int pm = u.pm, pn = u.pn;
        const bool ctx = pm < 16;
        const int rbase = pm * BM + wr * 64 + fr, cbase = pn * BM + wc * 32 + 8 * fq;
        if (!ctx && (pn == 7 || pn == 8)) {
            const float sgn = (fq < 2) ? -1.f : 1.f;
            float frq[8];
#pragma unroll
            for (int e = 0; e < 8; ++e) frq[e] = __builtin_amdgcn_exp2f(-(float)(8 * (fq & 1) + e) * 0.83048202372184058696f) * 0.15915494309189533577f;
#pragma unroll
            for (int ai = 0; ai < 2; ++ai)
#pragma unroll
                for (int m = 0; m < 4; ++m) {
                    const int r = rbase + ai * HALF + m * 16, t = (r - 4096) & 4095;
                    const float pos = (float)((wc & 1) ? (t & 63) : (t >> 6));
#pragma unroll
                    for (int bj = 0; bj < 2; ++bj) {
                        f32x4 v0 = acc[ai][bj][m][0], v1 = acc[ai][bj][m][1];
                        if (pn == 7 || bj == 0) {
                            float o[8];
#pragma unroll
                            for (int e = 0; e < 8; ++e) {
                                const float own = e < 4 ? v0[e] : v1[e - 4];
                                const float oth = __shfl_xor(own, 32);
                                const float rev = pos * frq[e];
                                const float sn = __builtin_amdgcn_sinf(rev), cs = __builtin_amdgcn_cosf(rev);
                                o[e] = own * cs + sgn * oth * sn;
                            }
                            v0 = (f32x4){o[0], o[1], o[2], o[3]}; v1 = (f32x4){o[4], o[5], o[6], o[7]};
                        }
                        u32x4 w; w.x = cvt_pk_bf16(v0[0], v0[1]); w.y = cvt_pk_bf16(v0[2], v0[3]); w.z = cvt_pk_bf16(v1[0], v1[1]); w.w = cvt_pk_bf16(v1[2], v1[3]);
                        *(GAS u32x4*)(P + (size_t)r * PROJ_N + cbase + bj * HALF) = w;
                    }
                }
        } else {
#pragma unroll
            for (int ai = 0; ai < 2; ++ai)
#pragma unroll
                for (int m = 0; m < 4; ++m) {
                    bf16_t* rowp = P + (size_t)(rbase + ai * HALF + m * 16) * PROJ_N + cbase;
#pragma unroll
                    for (int bj = 0; bj < 2; ++bj) {
                        const f32x4 v0 = acc[ai][bj][m][0], v1 = acc[ai][bj][m][1];
                        u32x4 w; w.x = cvt_pk_bf16(v0[0], v0[1]); w.y = cvt_pk_bf16(v0[2], v0[3]); w.z = cvt_pk_bf16(v1[0], v1[1]); w.w = cvt_pk_bf16(v1[2], v1[3]);
                        *(GAS u32x4*)(rowp + bj * HALF) = w;
                    }
                }
        }
        if (ctx && (pn == 8 || pn == 11 || pn == 12)) {
            const int width = pn == 8 ? 128 : 256;
            float* ob0 = out + (pn == 8 ? OUT_CK : pn == 11 ? OUT_DK : OUT_DV);
            float* ob1 = pn == 8 ? out + OUT_CV : ob0 + 128;
            const int coff = wc * 32 + 8 * fq;
#pragma unroll
            for (int ai = 0; ai < 2; ++ai)
#pragma unroll
                for (int m = 0; m < 4; ++m) {
                    const int r = rbase + ai * HALF + m * 16, b = r >> 8, t = r & 255;
                    const size_t ro = ((size_t)((b * 4 + layer) * 256 + t)) * width + coff;
                    *(GAS f32x4*)(ob0 + ro) = acc[ai][0][m][0]; *(GAS f32x4*)(ob0 + ro + 4) = acc[ai][0][m][1];
                    *(GAS f32x4*)(ob1 + ro) = acc[ai][1][m][0]; *(GAS f32x4*)(ob1 + ro + 4) = acc[ai][1][m][1];
                }
        }
        if (pn == 8 || pn == 12) {
            const int T = ctx ? 256 : 4096, nh = pn == 8 ? 2 : 4;
            bf16_t* vb = (pn == 8 ? VTC : VTD) + (ctx ? (size_t)0 : (pn == 8 ? VTC_LAT : VTD_LAT));
#pragma unroll
            for (int bj = 0; bj < 2; ++bj) {
                if (pn == 8 && bj == 0) continue;
                const int cl = (pn == 8 ? 0 : bj * HALF) + wc * 32 + 8 * fq, h = cl >> 6, d0 = cl & 63;
#pragma unroll
                for (int ai = 0; ai < 2; ++ai)
#pragma unroll
                    for (int m = 0; m < 4; ++m) {
                        const int r = rbase + ai * HALF + m * 16;
                        const int b = ctx ? (r >> 8) : ((r - 4096) >> 12), t = ctx ? (r & 255) : ((r - 4096) & 4095);
                        GAS bf16_t* vt = (GAS bf16_t*)(vb + ((size_t)((b * nh + h) * 64 + d0)) * T + t);
                        const f32x4 v0 = acc[ai][bj][m][0], v1 = acc[ai][bj][m][1];
                        const unsigned w0 = cvt_pk_bf16(v0[0], v0[1]), w1 = cvt_pk_bf16(v0[2], v0[3]), w2 = cvt_pk_bf16(v1[0], v1[1]), w3 = cvt_pk_bf16(v1[2], v1[3]);
                        vt[0] = (bf16_t)(w0 & 0xffff); vt[T] = (bf16_t)(w0 >> 16); vt[2 * T] = (bf16_t)(w1 & 0xffff); vt[3 * T] = (bf16_t)(w1 >> 16);
                        vt[4 * T] = (bf16_t)(w2 & 0xffff); vt[5 * T] = (bf16_t)(w2 >> 16); vt[6 * T] = (bf16_t)(w3 & 0xffff); vt[7 * T] = (bf16_t)(w3 >> 16);
                    }
            }
        }
    }
};

struct EpiOut {
    static constexpr bool PERM = true, AFTER_DRAIN = false;
    const float* xin; float* X; const float* gate;
    const float* xin_lat;
    __device__ __forceinline__ void operator()(const f32x4 (&acc)[2][2][4][2], const Unit& u, int wr, int wc, int fr, int fq) const {
#pragma unroll
        for (int ai = 0; ai < 2; ++ai)
#pragma unroll
            for (int m = 0; m < 4; ++m) {
                const int r = u.pm * BM + ai * HALF + wr * 64 + m * 16 + fr;
                const int cond = r < 4096 ? 0 : 1 + ((r - 4096) >> 12);
                const float* xr = r < 4096 ? xin + (size_t)r * 1024 : xin_lat + (size_t)(r - 4096) * 1024;
                const float* gr = gate + cond * 3072;
                float* xo = X + (size_t)r * 1024;
#pragma unroll
                for (int bj = 0; bj < 2; ++bj) {
                    const int c = u.pn * BM + bj * HALF + wc * 32 + 8 * fq;
                    const f32x4 g0 = *(const GAS f32x4*)(gr + c), g1 = *(const GAS f32x4*)(gr + c + 4);
                    const f32x4 x0 = *(const GAS f32x4*)(xr + c), x1 = *(const GAS f32x4*)(xr + c + 4);
                    *(GAS f32x4*)(xo + c) = x0 + g0 * acc[ai][bj][m][0];
                    *(GAS f32x4*)(xo + c + 4) = x1 + g1 * acc[ai][bj][m][1];
                }
            }
    }
};
template <class Epi, class Sched, bool ALIGN_EPI = false, bool SP2 = false>
__device__ __forceinline__ void gemm_phase(PG8_LAS unsigned char* lds, const Gemm g, const Sched& S, const Epi& E) {
    int tid = threadIdx.x; asm volatile("" : "+v"(tid)); const int wid = __builtin_amdgcn_readfirstlane(tid >> 6), lane = tid & 63, wr = wid >> 2, wc = wid & 3, fr = lane & 15, fq = lane >> 4;
    const int K = g.K, nt = K / BK;
    unsigned voffA[2], voffB[2];
#pragma unroll
    for (int i = 0; i < 2; ++i) { int R, C; stage_rc(tid * 16 + i * 8192, R, C); const int Rb = Epi::PERM ? ((R & ~31) + perm32(R & 31)) : R;
        voffA[i] = (unsigned)(R * K + C) * 2u; voffB[i] = (unsigned)(Rb * K + C) * 2u; }
    const size_t kstep = (size_t)(BK * 2);
    const size_t hstep = (size_t)HALF * K * 2;
    const size_t tstep = 2 * hstep;
    const unsigned ldsw = (unsigned)wid * 1024u;
    const int aoff = lds_byte(wr * 64 + fr, fq * 8), boff = lds_byte(wc * 32 + fr, fq * 8);
#define PG8_SA(b, h) (((b) * 2 + (h)) * HTB)
#define PG8_SB(b, h) ((4 + (b) * 2 + (h)) * HTB)
#define PG8_STAGE(bufoff, gbase, voff) do { _Pragma("unroll") for (int _i = 0; _i < 2; ++_i) \
        __builtin_amdgcn_global_load_lds((const unsigned*)((const char*)(gbase) + (voff)[_i]), (PG8_LAS unsigned*)(lds + (bufoff) + ldsw + _i * 8192), 16, 0, 0); } while (0)
#define PG8_LDA(dst, b, h) do { _Pragma("unroll") for (int m = 0; m < 4; ++m) _Pragma("unroll") for (int k = 0; k < 2; ++k) dst[m][k] = *(const PG8_LAS bf16x8*)(lds + PG8_SA(b, h) + aoff + m * 2048 + k * 1024); } while (0)
#define PG8_LDB(dst, b, h) do { _Pragma("unroll") for (int n = 0; n < 2; ++n) _Pragma("unroll") for (int k = 0; k < 2; ++k) dst[n][k] = *(const PG8_LAS bf16x8*)(lds + PG8_SB(b, h) + boff + n * 2048 + k * 1024); } while (0)
#define PG8_MMA(ai, bj, At, Bt) do { __builtin_amdgcn_s_setprio(1); _Pragma("unroll") for (int m = 0; m < 4; ++m) _Pragma("unroll") for (int n = 0; n < 2; ++n) _Pragma("unroll") for (int k = 0; k < 2; ++k) \
        acc[ai][bj][m][n] = __builtin_amdgcn_mfma_f32_16x16x32_bf16(Bt[n][k], At[m][k], acc[ai][bj][m][n], 0, 0, 0); __builtin_amdgcn_s_setprio(0); } while (0)
#define PG8_WAIT_V(n) asm volatile("s_waitcnt vmcnt(" #n ")" ::: "memory")
#define PG8_WAIT_L(n) asm volatile("s_waitcnt lgkmcnt(" #n ")" ::: "memory")
#define PG8_BAR __builtin_amdgcn_s_barrier()
#define PG8_SCHED __builtin_amdgcn_sched_barrier(0)
    Unit cur, nxt; int ui = 0;
    if (!S.next(0, cur)) return;
    f32x4 acc[2][2][4][2];
#pragma unroll
    for (int a = 0; a < 2; ++a)
#pragma unroll
        for (int b = 0; b < 2; ++b)
#pragma unroll
            for (int m = 0; m < 4; ++m)
#pragma unroll
                for (int n = 0; n < 2; ++n) acc[a][b][m][n] = (f32x4){0.f, 0.f, 0.f, 0.f};
    bf16x8 At[4][2], B0[2][2], B1[2][2];
    const char* cA = (const char*)g.A + (size_t)cur.pm * tstep; const char* cB = (const char*)g.Bt + (size_t)cur.pn * tstep;
    S.a_ready(cur);
    if constexpr (SP2) {
        PG8_STAGE(PG8_SB(0, 0), cB, voffB); PG8_STAGE(PG8_SB(0, 1), cB + hstep, voffB); PG8_STAGE(PG8_SA(0, 0), cA, voffA); PG8_STAGE(PG8_SA(0, 1), cA + hstep, voffA);
        if (wr == 1) PG8_BAR;
        PG8_WAIT_V(2); PG8_BAR;
        PG8_STAGE(PG8_SB(1, 0), cB + kstep, voffB); PG8_STAGE(PG8_SA(1, 0), cA + kstep, voffA); PG8_STAGE(PG8_SB(1, 1), cB + hstep + kstep, voffB);
        PG8_WAIT_V(6); PG8_BAR;
    } else {
        PG8_STAGE(PG8_SB(0, 0), cB, voffB); PG8_STAGE(PG8_SA(0, 0), cA, voffA); PG8_STAGE(PG8_SB(0, 1), cB + hstep, voffB); PG8_STAGE(PG8_SA(0, 1), cA + hstep, voffA);
        if (wr == 1) PG8_BAR;
        PG8_WAIT_V(4); PG8_BAR;
        PG8_STAGE(PG8_SB(1, 0), cB + kstep, voffB); PG8_STAGE(PG8_SA(1, 0), cA + kstep, voffA); PG8_STAGE(PG8_SB(1, 1), cB + hstep + kstep, voffB);
        PG8_WAIT_V(6); PG8_BAR;
    }
    for (;;) {
        const bool has_next = S.next(ui + 1, nxt);
        const char* nA = has_next ? (const char*)g.A + (size_t)nxt.pm * tstep : cA; const char* nB = has_next ? (const char*)g.Bt + (size_t)nxt.pn * tstep : cB;
        for (int t = 0; t < nt; t += 2) {
            const bool last = (t == nt - 2);
            const char* a1 = cA + (size_t)(t + 1) * kstep;
            const char* a2 = last ? nA : cA + (size_t)(t + 2) * kstep; const char* b2 = last ? nB : cB + (size_t)(t + 2) * kstep;
            const char* a3 = a2 + kstep; const char* b3 = b2 + kstep;
            if (last && has_next) S.a_ready(nxt);
            if constexpr (SP2) {
            PG8_LDB(B0, 0, 0); PG8_LDB(B1, 0, 1); PG8_SCHED; PG8_LDA(At, 0, 0); PG8_STAGE(PG8_SA(1, 1), a1 + hstep, voffA);
            PG8_WAIT_V(8); PG8_WAIT_L(0); PG8_BAR; PG8_MMA(0, 0, At, B0); PG8_MMA(0, 1, At, B1); PG8_BAR; PG8_SCHED;
            PG8_LDA(At, 0, 1); PG8_STAGE(PG8_SB(0, 0), b2, voffB); PG8_STAGE(PG8_SB(0, 1), b2 + hstep, voffB); PG8_STAGE(PG8_SA(0, 0), a2, voffA);
            PG8_WAIT_V(8); PG8_WAIT_L(0); PG8_BAR; PG8_MMA(1, 0, At, B0); PG8_MMA(1, 1, At, B1); PG8_BAR; PG8_SCHED;
            PG8_LDB(B0, 1, 0); PG8_LDB(B1, 1, 1); PG8_SCHED; PG8_LDA(At, 1, 0); PG8_STAGE(PG8_SA(0, 1), a2 + hstep, voffA);
            PG8_WAIT_V(8); PG8_WAIT_L(0); PG8_BAR; PG8_MMA(0, 0, At, B0); PG8_MMA(0, 1, At, B1); PG8_BAR; PG8_SCHED;
            PG8_LDA(At, 1, 1); PG8_STAGE(PG8_SB(1, 0), b3, voffB); PG8_STAGE(PG8_SB(1, 1), b3 + hstep, voffB); PG8_STAGE(PG8_SA(1, 0), a3, voffA);
            PG8_WAIT_V(8); PG8_WAIT_L(0); PG8_BAR; PG8_MMA(1, 0, At, B0); PG8_MMA(1, 1, At, B1); PG8_BAR; PG8_SCHED;
            } else {
            PG8_LDB(B0, 0, 0); PG8_SCHED; PG8_LDA(At, 0, 0); PG8_STAGE(PG8_SA(1, 1), a1 + hstep, voffA);
            PG8_WAIT_L(8); PG8_BAR; PG8_WAIT_L(0); PG8_MMA(0, 0, At, B0); PG8_BAR; PG8_SCHED;
            PG8_LDB(B1, 0, 1); PG8_STAGE(PG8_SB(0, 0), b2, voffB);
            PG8_BAR; PG8_WAIT_L(0); PG8_MMA(0, 1, At, B1); PG8_BAR;
            PG8_LDA(At, 0, 1); PG8_STAGE(PG8_SA(0, 0), a2, voffA);
            PG8_BAR; PG8_WAIT_L(0); PG8_MMA(1, 0, At, B0); PG8_BAR; PG8_SCHED;
            PG8_STAGE(PG8_SB(0, 1), b2 + hstep, voffB);
            PG8_WAIT_V(6); PG8_BAR; PG8_MMA(1, 1, At, B1); PG8_BAR;
            PG8_LDB(B0, 1, 0); PG8_SCHED; PG8_LDA(At, 1, 0); PG8_STAGE(PG8_SA(0, 1), a2 + hstep, voffA);
            PG8_WAIT_L(8); PG8_BAR; PG8_WAIT_L(0); PG8_MMA(0, 0, At, B0); PG8_BAR; PG8_SCHED;
            PG8_LDB(B1, 1, 1); PG8_STAGE(PG8_SB(1, 0), b3, voffB);
            PG8_BAR; PG8_WAIT_L(0); PG8_MMA(0, 1, At, B1); PG8_BAR;
            PG8_LDA(At, 1, 1); PG8_STAGE(PG8_SA(1, 0), a3, voffA);
            PG8_BAR; PG8_WAIT_L(0); PG8_MMA(1, 0, At, B0); PG8_BAR; PG8_SCHED;
            PG8_STAGE(PG8_SB(1, 1), b3 + hstep, voffB);
            PG8_WAIT_V(6); PG8_BAR; PG8_MMA(1, 1, At, B1); PG8_BAR;
            }
        }
        if constexpr (ALIGN_EPI) { if (wr == 0) PG8_BAR; }
        if constexpr (!Epi::AFTER_DRAIN) { E(acc, cur, wr, wc, fr, fq); S.done(cur); }
        if (!has_next) break;
#pragma unroll
        for (int a = 0; a < 2; ++a)
#pragma unroll
            for (int b = 0; b < 2; ++b)
#pragma unroll
                for (int m = 0; m < 4; ++m)
#pragma unroll
                    for (int n = 0; n < 2; ++n) acc[a][b][m][n] = (f32x4){0.f, 0.f, 0.f, 0.f};
        cur = nxt; cA = nA; cB = nB; ++ui;
        if constexpr (ALIGN_EPI) { if (wr == 1) PG8_BAR; }
    }
    PG8_WAIT_V(0);
    if constexpr (!ALIGN_EPI) { if (wr == 0) PG8_BAR; }
    PG8_BAR;
    if constexpr (Epi::AFTER_DRAIN) { E.fused(acc, cur, wr, wc, fr, fq, lds, wid, lane); S.done(cur); }
#undef PG8_SA
#undef PG8_SB
#undef PG8_STAGE
#undef PG8_LDA
#undef PG8_LDB
#undef PG8_MMA
#undef PG8_WAIT_V
#undef PG8_WAIT_L
#undef PG8_BAR
#undef PG8_SCHED
}
}
#define LAS __attribute__((address_space(3)))
typedef unsigned short bf16;
typedef unsigned v4u __attribute__((ext_vector_type(4)));
typedef unsigned v2u __attribute__((ext_vector_type(2)));
typedef float f32x4 __attribute__((ext_vector_type(4)));
typedef float f32x16 __attribute__((ext_vector_type(16)));
typedef short bf16x8 __attribute__((ext_vector_type(8)));
typedef short s16x4 __attribute__((ext_vector_type(4)));

constexpr int NTOK = 12288, DM = 1024, DIN = 3584, NLAYER = 4;
constexpr size_t MiB = 1u << 20;
constexpr size_t WS_WIN = 0, WS_WOUT = 28 * MiB, WS_MOD = 36 * MiB, WS_H = 37 * MiB, WS_P = 61 * MiB, WS_Y = 145 * MiB, WS_X = 169 * MiB,
                 WS_VTC = 217 * MiB, WS_VTD = 220 * MiB, WS_CKC = 226 * MiB, WS_CVTC = 227 * MiB, WS_CKD = 228 * MiB, WS_CVTD = 230 * MiB, WS_END = 232 * MiB;
constexpr int LDS_BYTES = 147456;
constexpr float LOG2E = 1.4426950408889634f;
constexpr float SC2 = 0.125f * 1.4426950408889634f;

struct Params { const float* in[19]; float* out; unsigned char* ws; };

__device__ __forceinline__ float bf2f(unsigned short b) { return __uint_as_float((unsigned)b << 16); }
__device__ __forceinline__ float bflo(unsigned w) { return __uint_as_float(w << 16); }
__device__ __forceinline__ float bfhi(unsigned w) { return __uint_as_float(w & 0xffff0000u); }
__device__ __forceinline__ unsigned pk2(float lo, float hi) { return pg8::cvt_pk_bf16(lo, hi); }
__device__ __forceinline__ float silu(float v) { return v / (1.f + __expf(-v)); }
__device__ __forceinline__ float wave_sum(float v) {
#pragma unroll
    for (int o = 1; o < 64; o <<= 1) v += __shfl_xor(v, o);
    return v;
}
__device__ __forceinline__ int opq_v(int x) { asm volatile("" : "+v"(x)); return x; }
__device__ __forceinline__ int opq_s(int x) { asm volatile("" : "+s"(x)); return x; }
template <class T> __device__ __forceinline__ T* opq_p(T* x) { asm volatile("" : "+s"(x)); return x; }
#define LDS_WAIT() asm volatile("s_waitcnt lgkmcnt(0)" ::: "memory")
#define MFMA32(a, b, c) __builtin_amdgcn_mfma_f32_32x32x16_bf16((a), (b), (c), 0, 0, 0)

__device__ __forceinline__ void transpose_item(const float* W, int K, int N, bf16* WT, LAS float* scr, int item, int lane) {
    const int nblk = N / 32, kb = item / nblk, nb = item % nblk, k0 = 64 * kb, n0 = 32 * nb;
#pragma unroll 8
    for (int i = 0; i < 32; ++i) { const int kk = 2 * i + (lane >> 5); scr[kk * 33 + (lane & 31)] = ((const GAS float*)W)[(size_t)(k0 + kk) * N + n0 + (lane & 31)]; }
    LDS_WAIT(); asm volatile("" ::: "memory");
    const int c = lane & 7;
#pragma unroll
    for (int j = 0; j < 4; ++j) { const int n = (lane >> 3) + 8 * j; const LAS float* s = scr + (8 * c) * 33 + n;
        v4u o; o.x = pk2(s[0 * 33], s[1 * 33]); o.y = pk2(s[2 * 33], s[3 * 33]); o.z = pk2(s[4 * 33], s[5 * 33]); o.w = pk2(s[6 * 33], s[7 * 33]);
        *(GAS v4u*)(WT + (size_t)(n0 + n) * K + k0 + 8 * c) = o; }
    LDS_WAIT(); asm volatile("" ::: "memory");
}

__device__ __forceinline__ void prep_phase(const Params& p, LAS unsigned char* lds) {
    const int tid = threadIdx.x, lane = tid & 63, wave = tid >> 6;
    const GAS float* c_lat = (const GAS float*)p.in[6]; const GAS float* c_ctx = (const GAS float*)p.in[7]; const GAS float* w_mod = (const GAS float*)p.in[9]; const GAS float* b_mod = (const GAS float*)p.in[10];
    GAS float* MOD = (GAS float*)(p.ws + WS_MOD);
    LAS float* sc = (LAS float*)lds;
    LAS float* red = sc + 3072;
    if ((int)blockIdx.x < 192) {
        for (int i = tid; i < 3072; i += 512) { const int cnd = i >> 10, k = i & 1023; const float v = cnd == 0 ? c_ctx[k] : c_lat[(cnd - 1) * 1024 + k]; sc[i] = silu(v); }
        __syncthreads();
        for (int it = blockIdx.x; it < 192; it += gridDim.x) {
            const int l = it / 48, n0 = (it % 48) * 64;
            const GAS float* W = w_mod + (size_t)l * 1024 * 3072 + n0 + lane;
            float a0 = 0.f, a1 = 0.f, a2 = 0.f;
            const int k0 = wave * 128;
#pragma unroll 8
            for (int k = 0; k < 128; ++k) { const float w = W[(size_t)(k0 + k) * 3072]; a0 += sc[k0 + k] * w; a1 += sc[1024 + k0 + k] * w; a2 += sc[2048 + k0 + k] * w; }
            red[(wave * 3 + 0) * 64 + lane] = a0; red[(wave * 3 + 1) * 64 + lane] = a1; red[(wave * 3 + 2) * 64 + lane] = a2;
            __syncthreads();
            if (tid < 192) { const int cnd = tid >> 6; float s = b_mod[l * 3072 + n0 + lane];
#pragma unroll
                for (int w = 0; w < 8; ++w) s += red[(w * 3 + cnd) * 64 + lane];
                MOD[(l * 3 + cnd) * 3072 + n0 + lane] = s; }
            __syncthreads();
        }
    }
    {
        LAS float* scr = (LAS float*)(lds + 20480 + wave * 8448);
        const int gw = blockIdx.x * 8 + wave, NGW = gridDim.x * 8;
        bf16* WinT = (bf16*)(p.ws + WS_WIN); bf16* WoutT = (bf16*)(p.ws + WS_WOUT);
        constexpr int I_IN = 16 * 112, I_OUT = 16 * 32, NITEMS = NLAYER * (I_IN + I_OUT);
        const bool balT = gridDim.x == 256;
        const int bx_ = blockIdx.x;
        const int first_ = balT ? (bx_ < 192 ? gw * 4 : 6144 + (gw - 1536) * 6) : gw, cnt_ = balT ? (bx_ < 192 ? 4 : 6) : (NITEMS - gw + NGW - 1) / NGW, step_ = balT ? 1 : NGW;
        for (int k_ = 0; k_ < cnt_; ++k_) {
            const int it = first_ + k_ * step_;
            const int l = it / (I_IN + I_OUT), r = it % (I_IN + I_OUT);
            if (r < I_IN) transpose_item(p.in[11] + (size_t)l * DM * DIN, DM, DIN, WinT + (size_t)l * DIN * DM, scr, r, lane);
            else transpose_item(p.in[12] + (size_t)l * DM * DM, DM, DM, WoutT + (size_t)l * DM * DM, scr, r - I_IN, lane);
        }
    }
    {
        const int gt = blockIdx.x * 512 + tid, NGT = gridDim.x * 512;
        for (int pass = 0; pass < 2; ++pass) {
            const int Hh = pass == 0 ? 2 : 4;
            const float* ck = p.in[pass == 0 ? 2 : 4]; const float* cv = p.in[pass == 0 ? 3 : 5];
            bf16* KO = (bf16*)(p.ws + (pass == 0 ? WS_CKC : WS_CKD)); bf16* VO = (bf16*)(p.ws + (pass == 0 ? WS_CVTC : WS_CVTD));
            const int nk = 8 * 512 * Hh * 8;
            for (int i = gt; i < nk; i += NGT) {
                const int d8 = i & 7, h = (i >> 3) % Hh, key = ((i >> 3) / Hh) & 511, bl = ((i >> 3) / Hh) >> 9;
                const float* s = ck + ((size_t)(bl * 512 + key) * Hh + h) * 64 + d8 * 8;
                const f32x4 a = *(const GAS f32x4*)s, b = *(const GAS f32x4*)(s + 4);
                v4u o; o.x = pk2(a[0], a[1]); o.y = pk2(a[2], a[3]); o.z = pk2(b[0], b[1]); o.w = pk2(b[2], b[3]);
                *(GAS v4u*)(KO + ((size_t)(bl * Hh + h) * 512 + key) * 64 + d8 * 8) = o;
            }
            const int nv = 8 * Hh * 64 * 64;
            for (int i = gt; i < nv; i += NGT) {
                const int d = i & 63, k8 = (i >> 6) & 63, h = (i >> 12) % Hh, bl = (i >> 12) / Hh;
                const GAS float* s = (const GAS float*)(cv + ((size_t)(bl * 512 + k8 * 8) * Hh + h) * 64 + d);
                float v[8];
#pragma unroll
                for (int e = 0; e < 8; ++e) v[e] = s[(size_t)e * Hh * 64];
                v4u o; o.x = pk2(v[0], v[1]); o.y = pk2(v[2], v[3]); o.z = pk2(v[4], v[5]); o.w = pk2(v[6], v[7]);
                *(GAS v4u*)(VO + ((size_t)(bl * Hh + h) * 64 + d) * 512 + k8 * 8) = o;
            }
        }
    }
}

template <bool FINAL>
__device__ __forceinline__ void norm_phase(const float* xc, const float* xl, const float* g, const float* mod, bf16* H, float* out) {
    const int tid_ = opq_v(threadIdx.x), bid_ = opq_s(blockIdx.x);
    const int lane = tid_ & 63, gw = bid_ * 8 + (tid_ >> 6), NGW = gridDim.x * 8;
    for (int row = gw; row < NTOK; row += NGW) {
        const float* xr = row < 4096 ? xc + (size_t)row * DM : xl + (size_t)(row - 4096) * DM;
        const int cond = row < 4096 ? 0 : 1 + ((row - 4096) >> 12);
        f32x4 v[4]; float s = 0.f;
#pragma unroll
        for (int j = 0; j < 4; ++j) { v[j] = *(const GAS f32x4*)(xr + 4 * (lane + 64 * j)); s += (v[j][0] * v[j][0] + v[j][1] * v[j][1]) + (v[j][2] * v[j][2] + v[j][3] * v[j][3]); }
        s = wave_sum(s);
        const float rstd = rsqrtf(s * (1.f / DM) + 1e-6f);
#pragma unroll
        for (int j = 0; j < 4; ++j) {
            const int col = 4 * (lane + 64 * j);
            const f32x4 gg = *(const GAS f32x4*)(g + col);
            f32x4 y = v[j] * rstd * gg;
            if (FINAL) { *(GAS f32x4*)(out + (size_t)row * DM + col) = y; }
            else {
                const f32x4 sh = *(const GAS f32x4*)(mod + cond * 3072 + col), scl = *(const GAS f32x4*)(mod + cond * 3072 + 1024 + col);
                y = y * (1.f + scl) + sh;
                v2u o; o.x = pk2(y[0], y[1]); o.y = pk2(y[2], y[3]);
                *(GAS v2u*)(H + (size_t)row * DM + col) = o;
            }
        }
    }
}

struct MaskNone { __device__ __forceinline__ float operator()(float s, int) const { return s * SC2; } };
struct MaskWin { int k0, qpos;
    __device__ __forceinline__ float operator()(float s, int kr) const { const int d = k0 + kr - qpos; return (d <= 128 && d >= -128) ? s * SC2 : -1e30f; } };
struct MaskNb { int kc0, qc, cs; const LAS float* rp;
    __device__ __forceinline__ float operator()(float s, int kr) const { const int kc = kc0 + kr; const bool ok = kc >= cs && kc < cs + 16; const int bi = ok ? kc - qc + 15 : 0; const float bv = rp[bi]; return ok ? s * SC2 + bv : -1e30f; } };

template <class MF>
__device__ __forceinline__ void attn_block(const bf16* krow, const bf16* vt, int vts, const bf16x8 (&qf)[4], f32x16& o0, f32x16& o1, float& m, float& l, const MF& mf, int hh) {
    bf16x8 kf[4];
#pragma unroll
    for (int ks = 0; ks < 4; ++ks) kf[ks] = *(const GAS bf16x8*)(krow + ks * 16 + hh * 8);
    s16x4 va[2][2][2];
#pragma unroll
    for (int dt = 0; dt < 2; ++dt)
#pragma unroll
        for (int s2 = 0; s2 < 2; ++s2) {
            const bf16* vp = vt + (size_t)dt * 32 * vts + 16 * s2 + 4 * hh;
            va[dt][s2][0] = *(const GAS s16x4*)vp; va[dt][s2][1] = *(const GAS s16x4*)(vp + 8);
        }
    f32x16 s;
#pragma unroll
    for (int i = 0; i < 16; ++i) s[i] = 0.f;
#pragma unroll
    for (int ks = 0; ks < 4; ++ks) s = MFMA32(kf[ks], qf[ks], s);
    float mx = -3e38f;
#pragma unroll
    for (int i = 0; i < 16; ++i) { const float t = mf(s[i], (i & 3) + 8 * (i >> 2) + 4 * hh); s[i] = t; mx = fmaxf(mx, t); }
    mx = fmaxf(mx, __shfl_xor(mx, 32));
    const float mn = fmaxf(m, mx);
    const float alpha = __builtin_amdgcn_exp2f(m - mn);
    float rs = 0.f;
#pragma unroll
    for (int i = 0; i < 16; ++i) { s[i] = __builtin_amdgcn_exp2f(s[i] - mn); rs += s[i]; }
    rs += __shfl_xor(rs, 32);
    l = l * alpha + rs; m = mn;
#pragma unroll
    for (int i = 0; i < 16; ++i) { o0[i] *= alpha; o1[i] *= alpha; }
#pragma unroll
    for (int s2 = 0; s2 < 2; ++s2) {
        v4u pw; pw.x = pk2(s[8 * s2 + 0], s[8 * s2 + 1]); pw.y = pk2(s[8 * s2 + 2], s[8 * s2 + 3]); pw.z = pk2(s[8 * s2 + 4], s[8 * s2 + 5]); pw.w = pk2(s[8 * s2 + 6], s[8 * s2 + 7]);
        const bf16x8 pb = __builtin_bit_cast(bf16x8, pw);
        const bf16x8 a0 = __builtin_shufflevector(va[0][s2][0], va[0][s2][1], 0, 1, 2, 3, 4, 5, 6, 7);
        const bf16x8 a1 = __builtin_shufflevector(va[1][s2][0], va[1][s2][1], 0, 1, 2, 3, 4, 5, 6, 7);
        o0 = MFMA32(a0, pb, o0);
        o1 = MFMA32(a1, pb, o1);
    }
}
__device__ __forceinline__ void attn_block_lds(const LAS bf16* Kt, const LAS bf16* Vt, const bf16x8 (&qf)[4], f32x16& o0, f32x16& o1, float& m, float& l,
                                               int xbase, int lo, int hi, const LAS float* rp, int boff, int hh, int l31, int vs = 72) {
    const int krow = (l31 & 19) | ((l31 & 4) << 1) | ((l31 & 8) >> 1);
    bf16x8 kf[4];
#pragma unroll
    for (int ks = 0; ks < 4; ++ks) kf[ks] = *(const LAS bf16x8*)(Kt + krow * 72 + ks * 16 + hh * 8);
    bf16x8 vf[2][2];
#pragma unroll
    for (int dt = 0; dt < 2; ++dt)
#pragma unroll
        for (int s2 = 0; s2 < 2; ++s2) vf[dt][s2] = *(const LAS bf16x8*)(Vt + (dt * 32 + l31) * vs + 16 * s2 + 8 * hh);
    f32x16 s;
#pragma unroll
    for (int i = 0; i < 16; ++i) s[i] = 0.f;
#pragma unroll
    for (int ks = 0; ks < 4; ++ks) s = MFMA32(kf[ks], qf[ks], s);
    float mx = -3e38f;
    if (rp != nullptr) {
#pragma unroll
        for (int i = 0; i < 16; ++i) { const int x = xbase + (i & 3) + 4 * ((i >> 2) & 1) + 8 * hh + 16 * (i >> 3); const bool ok = x >= lo && x <= hi;
            const float bv = rp[ok ? x + boff : 0]; const float t = ok ? s[i] * SC2 + bv : -1e30f; s[i] = t; mx = fmaxf(mx, t); }
    } else {
#pragma unroll
        for (int i = 0; i < 16; ++i) { const int x = xbase + (i & 3) + 4 * ((i >> 2) & 1) + 8 * hh + 16 * (i >> 3); const bool ok = x >= lo && x <= hi;
            const float t = ok ? s[i] * SC2 : -1e30f; s[i] = t; mx = fmaxf(mx, t); }
    }
    mx = fmaxf(mx, __shfl_xor(mx, 32));
    const float mn = fmaxf(m, mx);
    const float alpha = __builtin_amdgcn_exp2f(m - mn);
    float rs = 0.f;
#pragma unroll
    for (int i = 0; i < 16; ++i) { s[i] = __builtin_amdgcn_exp2f(s[i] - mn); rs += s[i]; }
    rs += __shfl_xor(rs, 32);
    l = l * alpha + rs; m = mn;
#pragma unroll
    for (int i = 0; i < 16; ++i) { o0[i] *= alpha; o1[i] *= alpha; }
#pragma unroll
    for (int s2 = 0; s2 < 2; ++s2) {
        v4u pw; pw.x = pk2(s[8 * s2 + 0], s[8 * s2 + 1]); pw.y = pk2(s[8 * s2 + 2], s[8 * s2 + 3]); pw.z = pk2(s[8 * s2 + 4], s[8 * s2 + 5]); pw.w = pk2(s[8 * s2 + 6], s[8 * s2 + 7]);
        const bf16x8 pb = __builtin_bit_cast(bf16x8, pw);
        o0 = MFMA32(vf[0][s2], pb, o0);
        o1 = MFMA32(vf[1][s2], pb, o1);
    }
}
__device__ __forceinline__ void attn_store(const f32x16& o0, const f32x16& o1, float l, const bf16* zrow, bf16* yrow, int hh) {
    const float inv = 1.f / l;
#pragma unroll
    for (int dt = 0; dt < 2; ++dt)
#pragma unroll
        for (int g = 0; g < 4; ++g) {
            const int d = dt * 32 + 8 * g + 4 * hh;
            const v2u zz = *(const GAS v2u*)(zrow + d);
            float y[4];
#pragma unroll
            for (int e = 0; e < 4; ++e) { const float ov = (dt == 0 ? o0[4 * g + e] : o1[4 * g + e]) * inv; const float z = (e & 1) ? bfhi(e < 2 ? zz.x : zz.y) : bflo(e < 2 ? zz.x : zz.y); y[e] = ov * silu(z); }
            v2u w; w.x = pk2(y[0], y[1]); w.y = pk2(y[2], y[3]);
            *(GAS v2u*)(yrow + d) = w;
        }
}
__device__ __forceinline__ void load_q(bf16x8 (&qf)[4], const bf16* qrow, int hh) {
#pragma unroll
    for (int ks = 0; ks < 4; ++ks) qf[ks] = *(const GAS bf16x8*)(qrow + ks * 16 + hh * 8);
}

__device__ __forceinline__ void mixer_phase(const Params& p, int layer, LAS unsigned char* lds) {
    const int tid = opq_v(threadIdx.x), lane = tid & 63, wave = tid >> 6, hh = lane >> 5, l31 = lane & 31;
    const int bid = opq_s(bid);
    unsigned char* ws = opq_p(p.ws);
    const bf16* P = (const bf16*)(ws + WS_P); bf16* Y = (bf16*)(ws + WS_Y);
    const bf16* VTC = (const bf16*)(ws + WS_VTC); const bf16* VTD = (const bf16*)(ws + WS_VTD);
    const bf16* CKC = (const bf16*)(ws + WS_CKC); const bf16* CVTC = (const bf16*)(ws + WS_CVTC);
    const bf16* CKD = (const bf16*)(ws + WS_CKD); const bf16* CVTD = (const bf16*)(ws + WS_CVTD);
    LAS float* rpb_s = (LAS float*)lds;
    LAS bf16* vT = (LAS bf16*)(lds + 8192);
    { const GAS float* rpb = (const GAS float*)(opq_p(p.in[17]) + layer * 1860); for (int i = tid; i < 1860; i += 512) rpb_s[i] = rpb[i] * LOG2E; }
    __syncthreads();

    {
        const float* w_s = opq_p(p.in[13]) + (size_t)layer * 4 * 128 * 128; const GAS float* b_s = (const GAS float*)(opq_p(p.in[14]) + layer * 4 * 128);
        for (int it = bid; it < 384; it += gridDim.x) {
            const int n = it >> 2, h = it & 3, row0 = n * 128;
            {
                const int q = tid >> 2, dq = (tid & 3) * 16;
                const bf16* src = P + (size_t)(row0 + q) * DIN + 256 + h * 64 + dq;
                const v4u a = *(const GAS v4u*)src, b = *(const GAS v4u*)(src + 8);
                float v[16];
                v[0] = bflo(a.x); v[1] = bfhi(a.x); v[2] = bflo(a.y); v[3] = bfhi(a.y); v[4] = bflo(a.z); v[5] = bfhi(a.z); v[6] = bflo(a.w); v[7] = bfhi(a.w);
                v[8] = bflo(b.x); v[9] = bfhi(b.x); v[10] = bflo(b.y); v[11] = bfhi(b.y); v[12] = bflo(b.z); v[13] = bfhi(b.z); v[14] = bflo(b.w); v[15] = bfhi(b.w);
                float ss = 0.f;
#pragma unroll
                for (int e = 0; e < 16; ++e) ss += v[e] * v[e];
                ss += __shfl_xor(ss, 1); ss += __shfl_xor(ss, 2);
                const float scl = rsqrtf(ss * (1.f / 64.f) + 1e-6f);
#pragma unroll
                for (int e = 0; e < 16; e += 2) { const unsigned w = pk2(v[e] * scl, v[e + 1] * scl); vT[(dq + e) * 136 + q] = (bf16)(w & 0xffff); vT[(dq + e + 1) * 136 + q] = (bf16)(w >> 16); }
            }
            __syncthreads();
            const int dt = wave & 1, pt = wave >> 1;
            f32x16 acc;
#pragma unroll
            for (int i = 0; i < 16; ++i) acc[i] = 0.f;
            const float* wrow = w_s + ((size_t)h * 128 + pt * 32 + l31) * 128 + hh * 8;
#pragma unroll
            for (int ks = 0; ks < 8; ++ks) {
                const bf16x8 A = *(const LAS bf16x8*)(vT + (dt * 32 + l31) * 136 + ks * 16 + hh * 8);
                const f32x4 w0 = *(const GAS f32x4*)(wrow + ks * 16), w1 = *(const GAS f32x4*)(wrow + ks * 16 + 4);
                v4u bw; bw.x = pk2(w0[0], w0[1]); bw.y = pk2(w0[2], w0[3]); bw.z = pk2(w1[0], w1[1]); bw.w = pk2(w1[2], w1[3]);
                acc = MFMA32(A, __builtin_bit_cast(bf16x8, bw), acc);
            }
            const int pp = pt * 32 + l31, row = row0 + pp;
            const float bias = b_s[h * 128 + pp];
#pragma unroll
            for (int g = 0; g < 4; ++g) {
                const int d = dt * 32 + 8 * g + 4 * hh;
                const v2u uu = *(const GAS v2u*)(P + (size_t)row * DIN + h * 64 + d), zz = *(const GAS v2u*)(P + (size_t)row * DIN + 512 + h * 64 + d);
                const float y0 = bflo(uu.x) * (acc[4 * g + 0] + bias) * silu(bflo(zz.x)), y1 = bfhi(uu.x) * (acc[4 * g + 1] + bias) * silu(bfhi(zz.x));
                const float y2 = bflo(uu.y) * (acc[4 * g + 2] + bias) * silu(bflo(zz.y)), y3 = bfhi(uu.y) * (acc[4 * g + 3] + bias) * silu(bfhi(zz.y));
                v2u w; w.x = pk2(y0, y1); w.y = pk2(y2, y3);
                *(GAS v2u*)(Y + (size_t)row * DM + h * 64 + d) = w;
            }
            __syncthreads();
        }
    }
    {
        const GAS float* wc = (const GAS float*)(opq_p(p.in[15]) + layer * 768);
        const int gt = bid * 512 + tid, NGT = gridDim.x * 512;
        for (int idx = gt; idx < NTOK * 32; idx += NGT) {
            const int row = idx >> 5, c8 = (idx & 31) * 8;
            const int t = row < 4096 ? (row & 255) : ((row - 4096) & 4095), L = row < 4096 ? 256 : 4096;
            const bf16* pr = P + (size_t)row * DIN;
            const v4u bb = *(const GAS v4u*)(pr + 768 + c8), zz = *(const GAS v4u*)(pr + 1536 + c8);
            const v4u c1 = *(const GAS v4u*)(pr + 1024 + c8), h1 = *(const GAS v4u*)(pr + 1280 + c8);
            v4u c0 = {0u, 0u, 0u, 0u}, h0 = c0, c2 = c0, h2 = c0;
            if (t > 0) { c0 = *(const GAS v4u*)(pr - DIN + 1024 + c8); h0 = *(const GAS v4u*)(pr - DIN + 1280 + c8); }
            if (t < L - 1) { c2 = *(const GAS v4u*)(pr + DIN + 1024 + c8); h2 = *(const GAS v4u*)(pr + DIN + 1280 + c8); }
            unsigned ow[4];
#pragma unroll
            for (int e = 0; e < 4; ++e) {
                const unsigned wb = e == 0 ? bb.x : e == 1 ? bb.y : e == 2 ? bb.z : bb.w, wz = e == 0 ? zz.x : e == 1 ? zz.y : e == 2 ? zz.z : zz.w;
                const unsigned wc0 = e == 0 ? c0.x : e == 1 ? c0.y : e == 2 ? c0.z : c0.w, wh0 = e == 0 ? h0.x : e == 1 ? h0.y : e == 2 ? h0.z : h0.w;
                const unsigned wc1 = e == 0 ? c1.x : e == 1 ? c1.y : e == 2 ? c1.z : c1.w, wh1 = e == 0 ? h1.x : e == 1 ? h1.y : e == 2 ? h1.z : h1.w;
                const unsigned wc2 = e == 0 ? c2.x : e == 1 ? c2.y : e == 2 ? c2.z : c2.w, wh2 = e == 0 ? h2.x : e == 1 ? h2.y : e == 2 ? h2.z : h2.w;
                const int ch = c8 + 2 * e;
                const float ylo = bflo(wb) * (wc[ch] * (bflo(wc0) * bflo(wh0)) + wc[256 + ch] * (bflo(wc1) * bflo(wh1)) + wc[512 + ch] * (bflo(wc2) * bflo(wh2))) * silu(bflo(wz));
                const float yhi = bfhi(wb) * (wc[ch + 1] * (bfhi(wc0) * bfhi(wh0)) + wc[256 + ch + 1] * (bfhi(wc1) * bfhi(wh1)) + wc[512 + ch + 1] * (bfhi(wc2) * bfhi(wh2))) * silu(bfhi(wz));
                ow[e] = pk2(ylo, yhi);
            }
            v4u o; o.x = ow[0]; o.y = ow[1]; o.z = ow[2]; o.w = ow[3];
            *(GAS v4u*)(Y + (size_t)row * DM + 256 + c8) = o;
        }
    }
    const bool ctx_lds = gridDim.x == 256;
    if (ctx_lds && bid < 128) {
        const int it = bid, h8 = it & 7, b = it >> 3, h = h8 & 3; const bool isC = h8 < 4;
        const int row0 = b * 256, qrow = row0 + wave * 32 + l31;
        LAS bf16* const Kb = (LAS bf16*)(lds + 32768);
        LAS bf16* const Vb = Kb + 256 * 72;
        const int kcol = isC ? 2048 + (h >> 1) * 64 : 2816 + h * 64;
        const bf16* const vt0 = isC ? VTC + ((size_t)((b * 2 + (h >> 1)) * 64)) * 256 : VTD + ((size_t)((b * 4 + h) * 64)) * 256;
#pragma unroll
        for (int j = 0; j < 4; ++j) {
            const int c = tid + 512 * j;
            const v4u kv = *(const GAS v4u*)(P + (size_t)(row0 + (c >> 3)) * DIN + kcol + (c & 7) * 8);
            const v4u vv = *(const GAS v4u*)(vt0 + (size_t)(c >> 5) * 256 + (c & 31) * 8);
            *(LAS v4u*)(Kb + (c >> 3) * 72 + (c & 7) * 8) = kv;
            *(LAS v4u*)(Vb + (c >> 5) * 264 + (c & 31) * 8) = vv;
        }
        bf16x8 qf[4];
        load_q(qf, P + (size_t)qrow * DIN + (isC ? 1792 : 2560) + h * 64, hh);
        f32x16 o0, o1;
#pragma unroll
        for (int i = 0; i < 16; ++i) { o0[i] = 0.f; o1[i] = 0.f; }
        const GAS float* sinkp0 = (const GAS float*)(opq_p(p.in[16]) + layer * 4);
        float m = isC ? sinkp0[h] * LOG2E : -1e30f, l = isC ? 1.f : 0.f;
        __syncthreads();
#pragma unroll 1
        for (int kb = 0; kb < 8; ++kb)
            attn_block_lds(Kb + kb * 32 * 72, Vb + kb * 32, qf, o0, o1, m, l, 0, -(1 << 30), 1 << 30, nullptr, 0, hh, l31, 264);
        attn_store(o0, o1, l, P + (size_t)qrow * DIN + (isC ? 2304 : 3328) + h * 64, Y + (size_t)qrow * DM + (isC ? 512 : 768) + h * 64, hh);
        __syncthreads();
    }
    if (ctx_lds && bid < 128) {
        const int j8 = bid & 15, hq = (bid >> 4) & 3, b = bid >> 6, kvh = hq >> 1, q0 = j8 * 256;
        const int rowbase = 4096 + b * 4096, qpos0 = q0 + wave * 32, qpos = qpos0 + l31, qrow = rowbase + qpos;
        LAS bf16* const Kb = (LAS bf16*)(lds + 32768);
        LAS bf16* const Vb = Kb + 128 * 72;
        const size_t cb = (size_t)((b * 4 + layer) * 2 + kvh);
        const bf16* const kc = CKC + cb * 512 * 64; const bf16* const vc = CVTC + cb * 64 * 512;
        const bf16* const kl = P + (size_t)rowbase * DIN + 2048 + kvh * 64; const bf16* const vl = VTC + pg8::VTC_LAT + ((size_t)((b * 2 + kvh) * 64)) * 4096;
        const int lstart = max(q0 - 128, 0), lend = min(q0 + 384, 4096), nsteps = 4 + (lend - lstart) / 128;
        bf16x8 qf[4];
        load_q(qf, P + (size_t)qrow * DIN + 1792 + hq * 64, hh);
        f32x16 o0, o1;
#pragma unroll
        for (int i = 0; i < 16; ++i) { o0[i] = 0.f; o1[i] = 0.f; }
        const GAS float* sinkp1 = (const GAS float*)(opq_p(p.in[16]) + layer * 4);
        float m = sinkp1[hq] * LOG2E, l = 1.f;
#pragma unroll 1
        for (int s_ = 0; s_ < nsteps; ++s_) {
            const bool isctx = s_ < 4;
            const int t0 = isctx ? s_ * 128 : lstart + (s_ - 4) * 128;
#pragma unroll
            for (int j = 0; j < 2; ++j) {
                const int c = tid + 512 * j, key = c >> 3, kch = c & 7, d = c >> 4, vch = c & 15;
                const v4u kv = *(const GAS v4u*)(isctx ? kc + (size_t)(t0 + key) * 64 + kch * 8 : kl + (size_t)(t0 + key) * DIN + kch * 8);
                const v4u vv = *(const GAS v4u*)(isctx ? vc + (size_t)d * 512 + t0 + vch * 8 : vl + (size_t)d * 4096 + t0 + vch * 8);
                *(LAS v4u*)(Kb + key * 72 + kch * 8) = kv;
                *(LAS v4u*)(Vb + d * 136 + vch * 8) = vv;
            }
            __syncthreads();
#pragma unroll 1
            for (int q4 = 0; q4 < 4; ++q4) {
                const int kb0 = t0 + q4 * 32;
                if (isctx) attn_block_lds(Kb + q4 * 32 * 72, Vb + q4 * 32, qf, o0, o1, m, l, 0, -(1 << 30), 1 << 30, nullptr, 0, hh, l31, 136);
                else if (kb0 + 31 >= qpos0 - 128 && kb0 <= qpos0 + 159) attn_block_lds(Kb + q4 * 32 * 72, Vb + q4 * 32, qf, o0, o1, m, l, kb0, qpos - 128, qpos + 128, nullptr, 0, hh, l31, 136);
            }
            __syncthreads();
        }
        attn_store(o0, o1, l, P + (size_t)qrow * DIN + 2304 + hq * 64, Y + (size_t)qrow * DM + 512 + hq * 64, hh);
    }
    const int gw = bid * 8 + wave, NGW = gridDim.x * 8;
    const GAS float* sinkp = (const GAS float*)(opq_p(p.in[16]) + layer * 4);
    for (int it = gw; it < 2048; it += NGW) {
        if (ctx_lds && it < 1024) continue;
        f32x16 o0, o1;
#pragma unroll
        for (int i = 0; i < 16; ++i) { o0[i] = 0.f; o1[i] = 0.f; }
        bf16x8 qf[4];
        if (it < 1024) {
            const int jlo = it & 7, g = (it >> 3) & 1, jhi = (it >> 4) & 15, kvh = (it >> 8) & 1, b = it >> 9;
            const int hq = kvh * 2 + g, j = jhi * 8 + jlo, qpos0 = j * 32, rowbase = 4096 + b * 4096, qrow = rowbase + qpos0 + l31;
            load_q(qf, P + (size_t)qrow * DIN + 1792 + hq * 64, hh);
            float m = sinkp[hq] * LOG2E, l = 1.f;
            const size_t cb = (size_t)((b * 4 + layer) * 2 + kvh);
            for (int kb = 0; kb < 16; ++kb)
                attn_block(CKC + (cb * 512 + kb * 32 + l31) * 64, CVTC + (cb * 64 + l31) * 512 + kb * 32, 512, qf, o0, o1, m, l, MaskNone(), hh);
            for (int i = 0; i < 9; ++i) {
                const int k0 = qpos0 - 128 + 32 * i;
                if (k0 < 0 || k0 >= 4096) continue;
                MaskWin mw; mw.k0 = k0; mw.qpos = qpos0 + l31;
                attn_block(P + (size_t)(rowbase + k0 + l31) * DIN + 2048 + kvh * 64, VTC + pg8::VTC_LAT + ((size_t)((b * 2 + kvh) * 64 + l31)) * 4096 + k0, 4096, qf, o0, o1, m, l, mw, hh);
            }
            attn_store(o0, o1, l, P + (size_t)qrow * DIN + 2304 + hq * 64, Y + (size_t)qrow * DM + 512 + hq * 64, hh);
        } else {
            const int i2 = it - 1024, ch = i2 & 1, r = (i2 >> 1) & 63, h = (i2 >> 7) & 3, b = i2 >> 9;
            const int qc = ch * 32 + l31, rowbase = 4096 + b * 4096, qrow = rowbase + r * 64 + qc;
            load_q(qf, P + (size_t)qrow * DIN + 2560 + h * 64, hh);
            float m = -1e30f, l = 0.f;
            const size_t cb = (size_t)((b * 4 + layer) * 4 + h);
            for (int kb = 0; kb < 16; ++kb)
                attn_block(CKD + (cb * 512 + kb * 32 + l31) * 64, CVTD + (cb * 64 + l31) * 512 + kb * 32, 512, qf, o0, o1, m, l, MaskNone(), hh);
            const int rs = min(max(r - 4, 0), 56);
            const int cs = min(max(qc - 8, 0), 48);
            for (int i = 0; i < 16; ++i) {
                const int kr = rs + (i >> 1), kc0 = (i & 1) * 32, t0 = kr * 64 + kc0;
                MaskNb mb; mb.kc0 = kc0; mb.qc = qc; mb.cs = cs; mb.rp = rpb_s + h * 465 + (kr - r + 7) * 31;
                attn_block(P + (size_t)(rowbase + t0 + l31) * DIN + 2816 + h * 64, VTD + pg8::VTD_LAT + ((size_t)((b * 4 + h) * 64 + l31)) * 4096 + t0, 4096, qf, o0, o1, m, l, mb, hh);
            }
            attn_store(o0, o1, l, P + (size_t)qrow * DIN + 3328 + h * 64, Y + (size_t)qrow * DM + 768 + h * 64, hh);
        }
    }
    if (!ctx_lds)
    for (int it = gw; it < 1024; it += NGW) {
        const int qb = it & 7, h8 = (it >> 3) & 7, b = it >> 6;
        const bool isC = h8 < 4; const int h = h8 & 3;
        const int row0 = b * 256, qrow = row0 + qb * 32 + l31;
        f32x16 o0, o1;
#pragma unroll
        for (int i = 0; i < 16; ++i) { o0[i] = 0.f; o1[i] = 0.f; }
        bf16x8 qf[4];
        load_q(qf, P + (size_t)qrow * DIN + (isC ? 1792 : 2560) + h * 64, hh);
        float m = isC ? sinkp[h] * LOG2E : -1e30f, l = isC ? 1.f : 0.f;
        const int kcol = isC ? 2048 + (h >> 1) * 64 : 2816 + h * 64;
        const bf16* vtb = isC ? VTC + ((size_t)((b * 2 + (h >> 1)) * 64 + l31)) * 256 : VTD + ((size_t)((b * 4 + h) * 64 + l31)) * 256;
        for (int kb = 0; kb < 8; ++kb)
            attn_block(P + (size_t)(row0 + kb * 32 + l31) * DIN + kcol, vtb + kb * 32, 256, qf, o0, o1, m, l, MaskNone(), hh);
        attn_store(o0, o1, l, P + (size_t)qrow * DIN + (isC ? 2304 : 3328) + h * 64, Y + (size_t)qrow * DM + (isC ? 512 : 768) + h * 64, hh);
    }
}

#define GRID_SYNC() do { asm volatile("s_waitcnt vmcnt(0) lgkmcnt(0)" ::: "memory"); grid.sync(); if (threadIdx.x < 64) asm volatile("buffer_inv sc1\n\ts_waitcnt vmcnt(0)" ::: "memory"); __syncthreads(); } while (0)
__global__ void __launch_bounds__(512, 2) hybrid_fwd(Params p) {
    extern __shared__ __attribute__((aligned(16))) unsigned char lds_raw[];
    LAS unsigned char* lds = (LAS unsigned char*)lds_raw;
    cg::grid_group grid = cg::this_grid();

    prep_phase(p, lds);
    GRID_SYNC();
#pragma unroll 1
    for (int layer = 0; layer < NLAYER; ++layer) {
        unsigned char* ws = opq_p(p.ws);
        float* MOD = (float*)(ws + WS_MOD);
        bf16* H = (bf16*)(ws + WS_H); bf16* P = (bf16*)(ws + WS_P); bf16* Y = (bf16*)(ws + WS_Y); float* X = (float*)(ws + WS_X);
        bf16* WinT = (bf16*)(ws + WS_WIN); bf16* WoutT = (bf16*)(ws + WS_WOUT);
        const float* xc = layer == 0 ? opq_p(p.in[0]) : X;
        const float* xl = layer == 0 ? opq_p(p.in[1]) : X + (size_t)4096 * DM;
        norm_phase<false>(xc, xl, opq_p(p.in[8]) + layer * DM, MOD + layer * 9216, H, nullptr);
        GRID_SYNC();
        {
            pg8::Gemm g{H, WinT + (size_t)layer * DIN * DM, NTOK, DIN, DM}; pg8::StaticOrder S; S.init(NTOK, DIN, (int)gridDim.x, opq_s(blockIdx.x));
            pg8::EpiProj E{P, opq_p(p.out), (bf16*)(ws + WS_VTC), (bf16*)(ws + WS_VTD), layer};
            pg8::gemm_phase<pg8::EpiProj, pg8::StaticOrder, true, true>(lds, g, S, E);
        }
        GRID_SYNC();
        mixer_phase(p, layer, lds);
        GRID_SYNC();
        {
            pg8::Gemm g{Y, WoutT + (size_t)layer * DM * DM, NTOK, DM, DM}; pg8::StaticOrder S; S.init(NTOK, DM, (int)gridDim.x, opq_s(blockIdx.x));
            pg8::EpiOut E{xc, X, MOD + layer * 9216 + 2048, xl};
            pg8::gemm_phase<pg8::EpiOut, pg8::StaticOrder, true, true>(lds, g, S, E);
        }
        GRID_SYNC();
    }
    { float* X = (float*)(p.ws + WS_X); norm_phase<true>(X, X + (size_t)4096 * DM, p.in[18], nullptr, nullptr, p.out); }
}

extern "C" void kernel_launch(void* const* d_in, const int* in_sizes, int n_in, void* d_out, int out_size, void* d_ws, size_t ws_size, hipStream_t stream) {
    static int grid = 0;
    if (grid == 0) {
        if (n_in != 19 || ws_size < WS_END) { fprintf(stderr, "kernel_launch: unexpected inputs (n_in %d, ws %zu)\n", n_in, ws_size); grid = -1; return; }
        int dev = 0, cus = 0, per_cu = 0;
        hipGetDevice(&dev);
        hipDeviceGetAttribute(&cus, hipDeviceAttributeMultiprocessorCount, dev);
        if (hipFuncSetAttribute((const void*)hybrid_fwd, hipFuncAttributeMaxDynamicSharedMemorySize, LDS_BYTES) != hipSuccess) { fprintf(stderr, "kernel_launch: hipFuncSetAttribute failed\n"); grid = -1; return; }
        if (hipOccupancyMaxActiveBlocksPerMultiprocessor(&per_cu, (const void*)hybrid_fwd, 512, LDS_BYTES) != hipSuccess || per_cu < 1) { fprintf(stderr, "kernel_launch: occupancy query says %d\n", per_cu); per_cu = 1; (void)hipGetLastError(); }
        if (per_cu > 1) per_cu = 1;
        grid = cus * per_cu;
    }
    if (grid < 0) return;
    Params p{};
    for (int i = 0; i < 19; ++i) p.in[i] = (const float*)d_in[i];
    p.out = (float*)d_out; p.ws = (unsigned char*)d_ws;
    void* args[] = {&p};
    hipError_t e = hipLaunchCooperativeKernel((const void*)hybrid_fwd, dim3(grid), dim3(512), args, LDS_BYTES, stream);
    if (e != hipSuccess) fprintf(stderr, "cooperative launch failed: %s (grid %d)\n", hipGetErrorString(e), grid);
}
```

```cpp
#include <hip/hip_runtime.h>
#include <hip/hip_cooperative_groups.h>
#include <cstdio>
#include <cstdint>
namespace cg = cooperative_groups;
namespace pg8 {
#define PG8_LAS __attribute__((address_space(3)))
#define GAS __attribute__((address_space(1)))
typedef unsigned short bf16_t;
typedef short bf16x8 __attribute__((ext_vector_type(8)));
typedef float f32x4 __attribute__((ext_vector_type(4)));
typedef unsigned u32x4 __attribute__((ext_vector_type(4)));
constexpr int BM = 256, BK = 64, HALF = 128, HTB = HALF * BK * 2  , STAGE_BYTES = 8 * HTB, NXCD = 8, WGM = 8;

__host__ __device__ __forceinline__ int lds_byte(int r, int c) { const int st = (r >> 4) * 2 + (c >> 5), rr = r & 15, cc = c & 31, ob = rr * 64 + cc * 2; return st * 1024 + (ob ^ (((ob >> 9) & 1) << 5)); }
__host__ __device__ __forceinline__ void stage_rc(int b, int& R, int& C) { const int st = b / 1024, sb = b % 1024, swz = sb ^ (((sb >> 9) & 1) << 5); R = (st >> 1) * 16 + swz / 64; C = (st & 1) * 32 + (swz % 64) / 2; }
__host__ __device__ __forceinline__ int perm32(int rho) { const int n = rho >> 4, i = rho & 15; return 8 * (i >> 2) + 4 * n + (i & 3); }

struct Unit { int pm, pn; };
struct Gemm { const bf16_t* A; const bf16_t* Bt; int M, N, K; };

struct StaticOrder {
    int nM, nN, nwg, G, c;
    __host__ __device__ void init(int M, int N, int G_, int c_) { nM = M / BM; nN = N / BM; nwg = nM * nN; G = G_; c = c_; }
    __host__ __device__ bool next(int i, Unit& u) const {
        const long L = (long)i * G + c; if (L >= nwg) return false;
        int wgid = (int)L; { const int q = nwg / NXCD, r = nwg % NXCD, xcd = wgid % NXCD, off = wgid / NXCD; wgid = (xcd < r ? xcd * (q + 1) : r * (q + 1) + (xcd - r) * q) + off; }
        const int nig = WGM * nN, gid = wgid / nig, fm = gid * WGM, gsz = (nM - fm) < WGM ? (nM - fm) : WGM;
        u.pm = fm + ((wgid % nig) % gsz); u.pn = (wgid % nig) / gsz; return true;
    }
    __device__ __forceinline__ void a_ready(const Unit&) const {}
    __device__ __forceinline__ void done(const Unit&) const {}
};
typedef float f32x2cv __attribute__((ext_vector_type(2)));
typedef __bf16 bf16x2cv __attribute__((ext_vector_type(2)));
__device__ __forceinline__ unsigned cvt_pk_bf16(float lo, float hi) { const f32x2cv v = {lo, hi}; const bf16x2cv b = __builtin_convertvector(v, bf16x2cv); return __builtin_bit_cast(unsigned, b); }
constexpr int PROJ_N = 3584;
constexpr size_t OUT_CK = 12582912, OUT_CV = 14680064, OUT_DK = 16777216, OUT_DV = 20971520;
constexpr size_t VTC_LAT = 524288, VTD_LAT = 1048576;

struct EpiProj {
    static constexpr bool PERM = true, AFTER_DRAIN = false;
    bf16_t* P; float* out; bf16_t* VTC; bf16_t* VTD; int layer;
    __device__ __forceinline__ void operator()(const f32x4 (&acc)[2][2][4][2], const Unit& u, int wr, int wc, int fr, int fq) const {
        const int pm = u.pm, pn = u.pn;
        const bool ctx = pm < 16;
        const int rbase = pm * BM + wr * 64 + fr, cbase = pn * BM + wc * 32 + 8 * fq;
        if (!ctx && (pn == 7 || pn == 8)) {
            const float sgn = (fq < 2) ? -1.f : 1.f;
            float frq[8];
#pragma unroll
            for (int e = 0; e < 8; ++e) frq[e] = __builtin_amdgcn_exp2f(-(float)(8 * (fq & 1) + e) * 0.83048202372184058696f) * 0.15915494309189533577f;
#pragma unroll
            for (int ai = 0; ai < 2; ++ai)
#pragma unroll
                for (int m = 0; m < 4; ++m) {
                    const int r = rbase + ai * HALF + m * 16, t = (r - 4096) & 4095;
                    const float pos = (float)((wc & 1) ? (t & 63) : (t >> 6));
#pragma unroll
                    for (int bj = 0; bj < 2; ++bj) {
                        f32x4 v0 = acc[ai][bj][m][0], v1 = acc[ai][bj][m][1];
                        if (pn == 7 || bj == 0) {
                            float o[8];
#pragma unroll
                            for (int e = 0; e < 8; ++e) {
                                const float own = e < 4 ? v0[e] : v1[e - 4];
                                const float oth = __shfl_xor(own, 32);
                                const float rev = pos * frq[e];
                                const float sn = __builtin_amdgcn_sinf(rev), cs = __builtin_amdgcn_cosf(rev);
                                o[e] = own * cs + sgn * oth * sn;
                            }
                            v0 = (f32x4){o[0], o[1], o[2], o[3]}; v1 = (f32x4){o[4], o[5], o[6], o[7]};
                        }
                        u32x4 w; w.x = cvt_pk_bf16(v0[0], v0[1]); w.y = cvt_pk_bf16(v0[2], v0[3]); w.z = cvt_pk_bf16(v1[0], v1[1]); w.w = cvt_pk_bf16(v1[2], v1[3]);
                        *(GAS u32x4*)(P + (size_t)r * PROJ_N + cbase + bj * HALF) = w;
                    }
                }
        } else {
#pragma unroll
            for (int ai = 0; ai < 2; ++ai)
#pragma unroll
                for (int m = 0; m < 4; ++m) {
                    bf16_t* rowp = P + (size_t)(rbase + ai * HALF + m * 16) * PROJ_N + cbase;
#pragma unroll
                    for (int bj = 0; bj < 2; ++bj) {
                        const f32x4 v0 = acc[ai][bj][m][0], v1 = acc[ai][bj][m][1];
                        u32x4 w; w.x = cvt_pk_bf16(v0[0], v0[1]); w.y = cvt_pk_bf16(v0[2], v0[3]); w.z = cvt_pk_bf16(v1[0], v1[1]); w.w = cvt_pk_bf16(v1[2], v1[3]);
                        *(GAS u32x4*)(rowp + bj * HALF) = w;
                    }
                }
        }
        if (ctx && (pn == 8 || pn == 11 || pn == 12)) {
            const int width = pn == 8 ? 128 : 256;
            float* ob0 = out + (pn == 8 ? OUT_CK : pn == 11 ? OUT_DK : OUT_DV);
            float* ob1 = pn == 8 ? out + OUT_CV : ob0 + 128;
            const int coff = wc * 32 + 8 * fq;
#pragma unroll
            for (int ai = 0; ai < 2; ++ai)
#pragma unroll
                for (int m = 0; m < 4; ++m) {
                    const int r = rbase + ai * HALF + m * 16, b = r >> 8, t = r & 255;
                    const size_t ro = ((size_t)((b * 4 + layer) * 256 + t)) * width + coff;
                    *(GAS f32x4*)(ob0 + ro) = acc[ai][0][m][0]; *(GAS f32x4*)(ob0 + ro + 4) = acc[ai][0][m][1];
                    *(GAS f32x4*)(ob1 + ro) = acc[ai][1][m][0]; *(GAS f32x4*)(ob1 + ro + 4) = acc[ai][1][m][1];
                }
        }
        if (pn == 8 || pn == 12) {
            const int T = ctx ? 256 : 4096, nh = pn == 8 ? 2 : 4;
            bf16_t* vb = (pn == 8 ? VTC : VTD) + (ctx ? (size_t)0 : (pn == 8 ? VTC_LAT : VTD_LAT));
#pragma unroll
            for (int bj = 0; bj < 2; ++bj) {
                if (pn == 8 && bj == 0) continue;
                const int cl = (pn == 8 ? 0 : bj * HALF) + wc * 32 + 8 * fq, h = cl >> 6, d0 = cl & 63;
#pragma unroll
                for (int ai = 0; ai < 2; ++ai)
#pragma unroll
                    for (int m = 0; m < 4; ++m) {
                        const int r = rbase + ai * HALF + m * 16;
                        const int b = ctx ? (r >> 8) : ((r - 4096) >> 12), t = ctx ? (r & 255) : ((r - 4096) & 4095);
                        GAS bf16_t* vt = (GAS bf16_t*)(vb + ((size_t)((b * nh + h) * 64 + d0)) * T + t);
                        const f32x4 v0 = acc[ai][bj][m][0], v1 = acc[ai][bj][m][1];
                        const unsigned w0 = cvt_pk_bf16(v0[0], v0[1]), w1 = cvt_pk_bf16(v0[2], v0[3]), w2 = cvt_pk_bf16(v1[0], v1[1]), w3 = cvt_pk_bf16(v1[2], v1[3]);
                        vt[0] = (bf16_t)(w0 & 0xffff); vt[T] = (bf16_t)(w0 >> 16); vt[2 * T] = (bf16_t)(w1 & 0xffff); vt[3 * T] = (bf16_t)(w1 >> 16);
                        vt[4 * T] = (bf16_t)(w2 & 0xffff); vt[5 * T] = (bf16_t)(w2 >> 16); vt[6 * T] = (bf16_t)(w3 & 0xffff); vt[7 * T] = (bf16_t)(w3 >> 16);
                    }
            }
        }
    }
};

struct EpiOut {
    static constexpr bool PERM = true, AFTER_DRAIN = false;
    const float* xin; float* X; const float* gate;
    const float* xin_lat;
    __device__ __forceinline__ void operator()(const f32x4 (&acc)[2][2][4][2], const Unit& u, int wr, int wc, int fr, int fq) const {
#pragma unroll
        for (int ai = 0; ai < 2; ++ai)
#pragma unroll
            for (int m = 0; m < 4; ++m) {
                const int r = u.pm * BM + ai * HALF + wr * 64 + m * 16 + fr;
                const int cond = r < 4096 ? 0 : 1 + ((r - 4096) >> 12);
                const float* xr = r < 4096 ? xin + (size_t)r * 1024 : xin_lat + (size_t)(r - 4096) * 1024;
                const float* gr = gate + cond * 3072;
                float* xo = X + (size_t)r * 1024;
#pragma unroll
                for (int bj = 0; bj < 2; ++bj) {
                    const int c = u.pn * BM + bj * HALF + wc * 32 + 8 * fq;
                    const f32x4 g0 = *(const GAS f32x4*)(gr + c), g1 = *(const GAS f32x4*)(gr + c + 4);
                    const f32x4 x0 = *(const GAS f32x4*)(xr + c), x1 = *(const GAS f32x4*)(xr + c + 4);
                    *(GAS f32x4*)(xo + c) = x0 + g0 * acc[ai][bj][m][0];
                    *(GAS f32x4*)(xo + c + 4) = x1 + g1 * acc[ai][bj][m][1];
                }
            }
    }
};
template <class Epi, class Sched, bool ALIGN_EPI = false, bool SP2 = false>
__device__ __forceinline__ void gemm_phase(PG8_LAS unsigned char* lds, const Gemm g, const Sched& S, const Epi& E) {
    int tid = threadIdx.x; asm volatile("" : "+v"(tid)); const int wid = __builtin_amdgcn_readfirstlane(tid >> 6), lane = tid & 63, wr = wid >> 2, wc = wid & 3, fr = lane & 15, fq = lane >> 4;
    const int K = g.K, nt = K / BK;
    unsigned voffA[2], voffB[2];
#pragma unroll
    for (int i = 0; i < 2; ++i) { int R, C; stage_rc(tid * 16 + i * 8192, R, C); const int Rb = Epi::PERM ? ((R & ~31) + perm32(R & 31)) : R;
        voffA[i] = (unsigned)(R * K + C) * 2u; voffB[i] = (unsigned)(Rb * K + C) * 2u; }
    const size_t kstep = (size_t)(BK * 2);
    const size_t hstep = (size_t)HALF * K * 2;
    const size_t tstep = 2 * hstep;
    const unsigned ldsw = (unsigned)wid * 1024u;
    const int aoff = lds_byte(wr * 64 + fr, fq * 8), boff = lds_byte(wc * 32 + fr, fq * 8);
#define PG8_SA(b, h) (((b) * 2 + (h)) * HTB)
#define PG8_SB(b, h) ((4 + (b) * 2 + (h)) * HTB)
#define PG8_STAGE(bufoff, gbase, voff) do { _Pragma("unroll") for (int _i = 0; _i < 2; ++_i) \
        __builtin_amdgcn_global_load_lds((const unsigned*)((const char*)(gbase) + (voff)[_i]), (PG8_LAS unsigned*)(lds + (bufoff) + ldsw + _i * 8192), 16, 0, 0); } while (0)
#define PG8_LDA(dst, b, h) do { _Pragma("unroll") for (int m = 0; m < 4; ++m) _Pragma("unroll") for (int k = 0; k < 2; ++k) dst[m][k] = *(const PG8_LAS bf16x8*)(lds + PG8_SA(b, h) + aoff + m * 2048 + k * 1024); } while (0)
#define PG8_LDB(dst, b, h) do { _Pragma("unroll") for (int n = 0; n < 2; ++n) _Pragma("unroll") for (int k = 0; k < 2; ++k) dst[n][k] = *(const PG8_LAS bf16x8*)(lds + PG8_SB(b, h) + boff + n * 2048 + k * 1024); } while (0)
#define PG8_MMA(ai, bj, At, Bt) do { __builtin_amdgcn_s_setprio(1); _Pragma("unroll") for (int m = 0; m < 4; ++m) _Pragma("unroll") for (int n = 0; n < 2; ++n) _Pragma("unroll") for (int k = 0; k < 2; ++k) \
        acc[ai][bj][m][n] = __builtin_amdgcn_mfma_f32_16x16x32_bf16(Bt[n][k], At[m][k], acc[ai][bj][m][n], 0, 0, 0); __builtin_amdgcn_s_setprio(0); } while (0)
#define PG8_WAIT_V(n) asm volatile("s_waitcnt vmcnt(" #n ")" ::: "memory")
#define PG8_WAIT_L(n) asm volatile("s_waitcnt lgkmcnt(" #n ")" ::: "memory")
#define PG8_BAR __builtin_amdgcn_s_barrier()
#define PG8_SCHED __builtin_amdgcn_sched_barrier(0)
    Unit cur, nxt; int ui = 0;
    if (!S.next(0, cur)) return;
    f32x4 acc[2][2][4][2];
#pragma unroll
    for (int a = 0; a < 2; ++a)
#pragma unroll
        for (int b = 0; b < 2; ++b)
#pragma unroll
            for (int m = 0; m < 4; ++m)
#pragma unroll
                for (int n = 0; n < 2; ++n) acc[a][b][m][n] = (f32x4){0.f, 0.f, 0.f, 0.f};
    bf16x8 At[4][2], B0[2][2], B1[2][2];
    const char* cA = (const char*)g.A + (size_t)cur.pm * tstep; const char* cB = (const char*)g.Bt + (size_t)cur.pn * tstep;
    S.a_ready(cur);
    if constexpr (SP2) {
        PG8_STAGE(PG8_SB(0, 0), cB, voffB); PG8_STAGE(PG8_SB(0, 1), cB + hstep, voffB); PG8_STAGE(PG8_SA(0, 0), cA, voffA); PG8_STAGE(PG8_SA(0, 1), cA + hstep, voffA);
        if (wr == 1) PG8_BAR;
        PG8_WAIT_V(2); PG8_BAR;
        PG8_STAGE(PG8_SB(1, 0), cB + kstep, voffB); PG8_STAGE(PG8_SA(1, 0), cA + kstep, voffA); PG8_STAGE(PG8_SB(1, 1), cB + hstep + kstep, voffB);
        PG8_WAIT_V(6); PG8_BAR;
    } else {
        PG8_STAGE(PG8_SB(0, 0), cB, voffB); PG8_STAGE(PG8_SA(0, 0), cA, voffA); PG8_STAGE(PG8_SB(0, 1), cB + hstep, voffB); PG8_STAGE(PG8_SA(0, 1), cA + hstep, voffA);
        if (wr == 1) PG8_BAR;
        PG8_WAIT_V(4); PG8_BAR;
        PG8_STAGE(PG8_SB(1, 0), cB + kstep, voffB); PG8_STAGE(PG8_SA(1, 0), cA + kstep, voffA); PG8_STAGE(PG8_SB(1, 1), cB + hstep + kstep, voffB);
        PG8_WAIT_V(6); PG8_BAR;
    }
    for (;;) {
        const bool has_next = S.next(ui + 1, nxt);
        const char* nA = has_next ? (const char*)g.A + (size_t)nxt.pm * tstep : cA; const char* nB = has_next ? (const char*)g.Bt + (size_t)nxt.pn * tstep : cB;
        for (int t = 0; t < nt; t += 2) {
            const bool last = (t == nt - 2);
            const char* a1 = cA + (size_t)(t + 1) * kstep;
            const char* a2 = last ? nA : cA + (size_t)(t + 2) * kstep; const char* b2 = last ? nB : cB + (size_t)(t + 2) * kstep;
            const char* a3 = a2 + kstep; const char* b3 = b2 + kstep;
            if (last && has_next) S.a_ready(nxt);
            if constexpr (SP2) {
            PG8_LDB(B0, 0, 0); PG8_LDB(B1, 0, 1); PG8_SCHED; PG8_LDA(At, 0, 0); PG8_STAGE(PG8_SA(1, 1), a1 + hstep, voffA);
            PG8_WAIT_V(8); PG8_WAIT_L(0); PG8_BAR; PG8_MMA(0, 0, At, B0); PG8_MMA(0, 1, At, B1); PG8_BAR; PG8_SCHED;
            PG8_LDA(At, 0, 1); PG8_STAGE(PG8_SB(0, 0), b2, voffB); PG8_STAGE(PG8_SB(0, 1), b2 + hstep, voffB); PG8_STAGE(PG8_SA(0, 0), a2, voffA);
            PG8_WAIT_V(8); PG8_WAIT_L(0); PG8_BAR; PG8_MMA(1, 0, At, B0); PG8_MMA(1, 1, At, B1); PG8_BAR; PG8_SCHED;
            PG8_LDB(B0, 1, 0); PG8_LDB(B1, 1, 1); PG8_SCHED; PG8_LDA(At, 1, 0); PG8_STAGE(PG8_SA(0, 1), a2 + hstep, voffA);
            PG8_WAIT_V(8); PG8_WAIT_L(0); PG8_BAR; PG8_MMA(0, 0, At, B0); PG8_MMA(0, 1, At, B1); PG8_BAR; PG8_SCHED;
            PG8_LDA(At, 1, 1); PG8_STAGE(PG8_SB(1, 0), b3, voffB); PG8_STAGE(PG8_SB(1, 1), b3 + hstep, voffB); PG8_STAGE(PG8_SA(1, 0), a3, voffA);
            PG8_WAIT_V(8); PG8_WAIT_L(0); PG8_BAR; PG8_MMA(1, 0, At, B0); PG8_MMA(1, 1, At, B1); PG8_BAR; PG8_SCHED;
            } else {
            PG8_LDB(B0, 0, 0); PG8_SCHED; PG8_LDA(At, 0, 0); PG8_STAGE(PG8_SA(1, 1), a1 + hstep, voffA);
            PG8_WAIT_L(8); PG8_BAR; PG8_WAIT_L(0); PG8_MMA(0, 0, At, B0); PG8_BAR; PG8_SCHED;
            PG8_LDB(B1, 0, 1); PG8_STAGE(PG8_SB(0, 0), b2, voffB);
            PG8_BAR; PG8_WAIT_L(0); PG8_MMA(0, 1, At, B1); PG8_BAR;
            PG8_LDA(At, 0, 1); PG8_STAGE(PG8_SA(0, 0), a2, voffA);
            PG8_BAR; PG8_WAIT_L(0); PG8_MMA(1, 0, At, B0); PG8_BAR; PG8_SCHED;
            PG8_STAGE(PG8_SB(0, 1), b2 + hstep, voffB);
            PG8_WAIT_V(6); PG8_BAR; PG8_MMA(1, 1, At, B1); PG8_BAR;
            PG8_LDB(B0, 1, 0); PG8_SCHED; PG8_LDA(At, 1, 0); PG8_STAGE(PG8_SA(0, 1), a2 + hstep, voffA);
            PG8_WAIT_L(8); PG8_BAR; PG8_WAIT_L(0); PG8_MMA(0, 0, At, B0); PG8_BAR; PG8_SCHED;
            PG8_LDB(B1, 1, 1); PG8_STAGE(PG8_SB(1, 0), b3, voffB);
            PG8_BAR; PG8_WAIT_L(0); PG8_MMA(0, 1, At, B1); PG8_BAR;
            PG8_LDA(At, 1, 1); PG8_STAGE(PG8_SA(1, 0), a3, voffA);
            PG8_BAR; PG8_WAIT_L(0); PG8_MMA(1, 0, At, B0); PG8_BAR; PG8_SCHED;
            PG8_STAGE(PG8_SB(1, 1), b3 + hstep, voffB);
            PG8_WAIT_V(6); PG8_BAR; PG8_MMA(1, 1, At, B1); PG8_BAR;
            }
        }
        if constexpr (ALIGN_EPI) { if (wr == 0) PG8_BAR; }
        if constexpr (!Epi::AFTER_DRAIN) { E(acc, cur, wr, wc, fr, fq); S.done(cur); }
        if (!has_next) break;
#pragma unroll
        for (int a = 0; a < 2; ++a)
#pragma unroll
            for (int b = 0; b < 2; ++b)
#pragma unroll
                for (int m = 0; m < 4; ++m)
#pragma unroll
                    for (int n = 0; n < 2; ++n) acc[a][b][m][n] = (f32x4){0.f, 0.f, 0.f, 0.f};
        cur = nxt; cA = nA; cB = nB; ++ui;
        if constexpr (ALIGN_EPI) { if (wr == 1) PG8_BAR; }
    }
    PG8_WAIT_V(0);
    if constexpr (!ALIGN_EPI) { if (wr == 0) PG8_BAR; }
    PG8_BAR;
    if constexpr (Epi::AFTER_DRAIN) { E.fused(acc, cur, wr, wc, fr, fq, lds, wid, lane); S.done(cur); }
#undef PG8_SA
#undef PG8_SB
#undef PG8_STAGE
#undef PG8_LDA
#undef PG8_LDB
#undef PG8_MMA
#undef PG8_WAIT_V
#undef PG8_WAIT_L
#undef PG8_BAR
#undef PG8_SCHED
}
}
#define LAS __attribute__((address_space(3)))
typedef unsigned short bf16;
typedef unsigned v4u __attribute__((ext_vector_type(4)));
typedef unsigned v2u __attribute__((ext_vector_type(2)));
typedef float f32x4 __attribute__((ext_vector_type(4)));
typedef float f32x16 __attribute__((ext_vector_type(16)));
typedef short bf16x8 __attribute__((ext_vector_type(8)));
typedef short s16x4 __attribute__((ext_vector_type(4)));

constexpr int NTOK = 12288, DM = 1024, DIN = 3584, NLAYER = 4;
constexpr size_t MiB = 1u << 20;
constexpr size_t WS_WIN = 0, WS_WOUT = 28 * MiB, WS_MOD = 36 * MiB, WS_H = 37 * MiB, WS_P = 61 * MiB, WS_Y = 145 * MiB, WS_X = 169 * MiB,
                 WS_VTC = 217 * MiB, WS_VTD = 220 * MiB, WS_CKC = 226 * MiB, WS_CVTC = 227 * MiB, WS_CKD = 228 * MiB, WS_CVTD = 230 * MiB, WS_END = 232 * MiB;
constexpr int LDS_BYTES = 147456;
constexpr float LOG2E = 1.4426950408889634f;
constexpr float SC2 = 0.125f * 1.4426950408889634f;

struct Params { const float* in[19]; float* out; unsigned char* ws; };

__device__ __forceinline__ float bf2f(unsigned short b) { return __uint_as_float((unsigned)b << 16); }
__device__ __forceinline__ float bflo(unsigned w) { return __uint_as_float(w << 16); }
__device__ __forceinline__ float bfhi(unsigned w) { return __uint_as_float(w & 0xffff0000u); }
__device__ __forceinline__ unsigned pk2(float lo, float hi) { return pg8::cvt_pk_bf16(lo, hi); }
__device__ __forceinline__ float silu(float v) { return v / (1.f + __expf(-v)); }
__device__ __forceinline__ float wave_sum(float v) {
#pragma unroll
    for (int o = 1; o < 64; o <<= 1) v += __shfl_xor(v, o);
    return v;
}
__device__ __forceinline__ int opq_v(int x) { asm volatile("" : "+v"(x)); return x; }
__device__ __forceinline__ int opq_s(int x) { asm volatile("" : "+s"(x)); return x; }
template <class T> __device__ __forceinline__ T* opq_p(T* x) { asm volatile("" : "+s"(x)); return x; }
#define LDS_WAIT() asm volatile("s_waitcnt lgkmcnt(0)" ::: "memory")
#define MFMA32(a, b, c) __builtin_amdgcn_mfma_f32_32x32x16_bf16((a), (b), (c), 0, 0, 0)

__device__ __forceinline__ void transpose_item(const float* W, int K, int N, bf16* WT, LAS float* scr, int item, int lane) {
    const int nblk = N / 32, kb = item / nblk, nb = item % nblk, k0 = 64 * kb, n0 = 32 * nb;
#pragma unroll 8
    for (int i = 0; i < 32; ++i) { const int kk = 2 * i + (lane >> 5); scr[kk * 33 + (lane & 31)] = ((const GAS float*)W)[(size_t)(k0 + kk) * N + n0 + (lane & 31)]; }
    LDS_WAIT(); asm volatile("" ::: "memory");
    const int c = lane & 7;
#pragma unroll
    for (int j = 0; j < 4; ++j) { const int n = (lane >> 3) + 8 * j; const LAS float* s = scr + (8 * c) * 33 + n;
        v4u o; o.x = pk2(s[0 * 33], s[1 * 33]); o.y = pk2(s[2 * 33], s[3 * 33]); o.z = pk2(s[4 * 33], s[5 * 33]); o.w = pk2(s[6 * 33], s[7 * 33]);
        *(GAS v4u*)(WT + (size_t)(n0 + n) * K + k0 + 8 * c) = o; }
    LDS_WAIT(); asm volatile("" ::: "memory");
}

__device__ __forceinline__ void prep_phase(const Params& p, LAS unsigned char* lds) {
    const int tid = threadIdx.x, lane = tid & 63, wave = tid >> 6;
    const GAS float* c_lat = (const GAS float*)p.in[6]; const GAS float* c_ctx = (const GAS float*)p.in[7]; const GAS float* w_mod = (const GAS float*)p.in[9]; const GAS float* b_mod = (const GAS float*)p.in[10];
    GAS float* MOD = (GAS float*)(p.ws + WS_MOD);
    LAS float* sc = (LAS float*)lds;
    LAS float* red = sc + 3072;
    if ((int)blockIdx.x < 192) {
        for (int i = tid; i < 3072; i += 512) { const int cnd = i >> 10, k = i & 1023; const float v = cnd == 0 ? c_ctx[k] : c_lat[(cnd - 1) * 1024 + k]; sc[i] = silu(v); }
        __syncthreads();
        for (int it = blockIdx.x; it < 192; it += gridDim.x) {
            const int l = it / 48, n0 = (it % 48) * 64;
            const GAS float* W = w_mod + (size_t)l * 1024 * 3072 + n0 + lane;
            float a0 = 0.f, a1 = 0.f, a2 = 0.f;
            const int k0 = wave * 128;
#pragma unroll 8
            for (int k = 0; k < 128; ++k) { const float w = W[(size_t)(k0 + k) * 3072]; a0 += sc[k0 + k] * w; a1 += sc[1024 + k0 + k] * w; a2 += sc[2048 + k0 + k] * w; }
            red[(wave * 3 + 0) * 64 + lane] = a0; red[(wave * 3 + 1) * 64 + lane] = a1; red[(wave * 3 + 2) * 64 + lane] = a2;
            __syncthreads();
            if (tid < 192) { const int cnd = tid >> 6; float s = b_mod[l * 3072 + n0 + lane];
#pragma unroll
                for (int w = 0; w < 8; ++w) s += red[(w * 3 + cnd) * 64 + lane];
                MOD[(l * 3 + cnd) * 3072 + n0 + lane] = s; }
            __syncthreads();
        }
    }
    {
        LAS float* scr = (LAS float*)(lds + 20480 + wave * 8448);
        const int gw = blockIdx.x * 8 + wave, NGW = gridDim.x * 8;
        bf16* WinT = (bf16*)(p.ws + WS_WIN); bf16* WoutT = (bf16*)(p.ws + WS_WOUT);
        constexpr int I_IN = 16 * 112, I_OUT = 16 * 32, NITEMS = NLAYER * (I_IN + I_OUT);
        const bool balT = gridDim.x == 256;
        const int bx_ = blockIdx.x;
        const int first_ = balT ? (bx_ < 192 ? gw * 4 : 6144 + (gw - 1536) * 6) : gw, cnt_ = balT ? (bx_ < 192 ? 4 : 6) : (NITEMS - gw + NGW - 1) / NGW, step_ = balT ? 1 : NGW;
        for (int k_ = 0; k_ < cnt_; ++k_) {
            const int it = first_ + k_ * step_;
            const int l = it / (I_IN + I_OUT), r = it % (I_IN + I_OUT);
            if (r < I_IN) transpose_item(p.in[11] + (size_t)l * DM * DIN, DM, DIN, WinT + (size_t)l * DIN * DM, scr, r, lane);
            else transpose_item(p.in[12] + (size_t)l * DM * DM, DM, DM, WoutT + (size_t)l * DM * DM, scr, r - I_IN, lane);
        }
    }
    {
        const int gt = blockIdx.x * 512 + tid, NGT = gridDim.x * 512;
        for (int pass = 0; pass < 2; ++pass) {
            const int Hh = pass == 0 ? 2 : 4;
            const float* ck = p.in[pass == 0 ? 2 : 4]; const float* cv = p.in[pass == 0 ? 3 : 5];
            bf16* KO = (bf16*)(p.ws + (pass == 0 ? WS_CKC : WS_CKD)); bf16* VO = (bf16*)(p.ws + (pass == 0 ? WS_CVTC : WS_CVTD));
            const int nk = 8 * 512 * Hh * 8;
            for (int i = gt; i < nk; i += NGT) {
                const int d8 = i & 7, h = (i >> 3) % Hh, key = ((i >> 3) / Hh) & 511, bl = ((i >> 3) / Hh) >> 9;
                const float* s = ck + ((size_t)(bl * 512 + key) * Hh + h) * 64 + d8 * 8;
                const f32x4 a = *(const GAS f32x4*)s, b = *(const GAS f32x4*)(s + 4);
                v4u o; o.x = pk2(a[0], a[1]); o.y = pk2(a[2], a[3]); o.z = pk2(b[0], b[1]); o.w = pk2(b[2], b[3]);
                *(GAS v4u*)(KO + ((size_t)(bl * Hh + h) * 512 + key) * 64 + d8 * 8) = o;
            }
            const int nv = 8 * Hh * 64 * 64;
            for (int i = gt; i < nv; i += NGT) {
                const int d = i & 63, k8 = (i >> 6) & 63, h = (i >> 12) % Hh, bl = (i >> 12) / Hh;
                const GAS float* s = (const GAS float*)(cv + ((size_t)(bl * 512 + k8 * 8) * Hh + h) * 64 + d);
                float v[8];
#pragma unroll
                for (int e = 0; e < 8; ++e) v[e] = s[(size_t)e * Hh * 64];
                v4u o; o.x = pk2(v[0], v[1]); o.y = pk2(v[2], v[3]); o.z = pk2(v[4], v[5]); o.w = pk2(v[6], v[7]);
                *(GAS v4u*)(VO + ((size_t)(bl * Hh + h) * 64 + d) * 512 + k8 * 8) = o;
            }
        }
    }
}

template <bool FINAL>
__device__ __forceinline__ void norm_phase(const float* xc, const float* xl, const float* g, const float* mod, bf16* H, float* out) {
    const int tid_ = opq_v(threadIdx.x), bid_ = opq_s(blockIdx.x);
    const int lane = tid_ & 63, gw = bid_ * 8 + (tid_ >> 6), NGW = gridDim.x * 8;
    for (int row = gw; row < NTOK; row += NGW) {
        const float* xr = row < 4096 ? xc + (size_t)row * DM : xl + (size_t)(row - 4096) * DM;
        const int cond = row < 4096 ? 0 : 1 + ((row - 4096) >> 12);
        f32x4 v[4]; float s = 0.f;
#pragma unroll
        for (int j = 0; j < 4; ++j) { v[j] = *(const GAS f32x4*)(xr + 4 * (lane + 64 * j)); s += (v[j][0] * v[j][0] + v[j][1] * v[j][1]) + (v[j][2] * v[j][2] + v[j][3] * v[j][3]); }
        s = wave_sum(s);
        const float rstd = rsqrtf(s * (1.f / DM) + 1e-6f);
#pragma unroll
        for (int j = 0; j < 4; ++j) {
            const int col = 4 * (lane + 64 * j);
            const f32x4 gg = *(const GAS f32x4*)(g + col);
            f32x4 y = v[j] * rstd * gg;
            if (FINAL) { *(GAS f32x4*)(out + (size_t)row * DM + col) = y; }
            else {
                const f32x4 sh = *(const GAS f32x4*)(mod + cond * 3072 + col), scl = *(const GAS f32x4*)(mod + cond * 3072 + 1024 + col);
                y = y * (1.f + scl) + sh;
                v2u o; o.x = pk2(y[0], y[1]); o.y = pk2(y[2], y[3]);
                *(GAS v2u*)(H + (size_t)row * DM + col) = o;
            }
        }
    }
}

struct MaskNone { __device__ __forceinline__ float operator()(float s, int) const { return s * SC2; } };
struct MaskWin { int k0, qpos;
    __device__ __forceinline__ float operator()(float s, int kr) const { const int d = k0 + kr - qpos; return (d <= 128 && d >= -128) ? s * SC2 : -1e30f; } };
struct MaskNb { int kc0, qc, cs; const LAS float* rp;
    __device__ __forceinline__ float operator()(float s, int kr) const { const int kc = kc0 + kr; const bool ok = kc >= cs && kc < cs + 16; const int bi = ok ? kc - qc + 15 : 0; const float bv = rp[bi]; return ok ? s * SC2 + bv : -1e30f; } };

template <class MF>
__device__ __forceinline__ void attn_block(const bf16* krow, const bf16* vt, int vts, const bf16x8 (&qf)[4], f32x16& o0, f32x16& o1, float& m, float& l, const MF& mf, int hh) {
    bf16x8 kf[4];
#pragma unroll
    for (int ks = 0; ks < 4; ++ks) kf[ks] = *(const GAS bf16x8*)(krow + ks * 16 + hh * 8);
    s16x4 va[2][2][2];
#pragma unroll
    for (int dt = 0; dt < 2; ++dt)
#pragma unroll
        for (int s2 = 0; s2 < 2; ++s2) {
            const bf16* vp = vt + (size_t)dt * 32 * vts + 16 * s2 + 4 * hh;
            va[dt][s2][0] = *(const GAS s16x4*)vp; va[dt][s2][1] = *(const GAS s16x4*)(vp + 8);
        }
    f32x16 s;
#pragma unroll
    for (int i = 0; i < 16; ++i) s[i] = 0.f;
#pragma unroll
    for (int ks = 0; ks < 4; ++ks) s = MFMA32(kf[ks], qf[ks], s);
    float mx = -3e38f;
#pragma unroll
    for (int i = 0; i < 16; ++i) { const float t = mf(s[i], (i & 3) + 8 * (i >> 2) + 4 * hh); s[i] = t; mx = fmaxf(mx, t); }
    mx = fmaxf(mx, __shfl_xor(mx, 32));
    const float mn = fmaxf(m, mx);
    const float alpha = __builtin_amdgcn_exp2f(m - mn);
    float rs = 0.f;
#pragma unroll
    for (int i = 0; i < 16; ++i) { s[i] = __builtin_amdgcn_exp2f(s[i] - mn); rs += s[i]; }
    rs += __shfl_xor(rs, 32);
    l = l * alpha + rs; m = mn;
#pragma unroll
    for (int i = 0; i < 16; ++i) { o0[i] *= alpha; o1[i] *= alpha; }
#pragma unroll
    for (int s2 = 0; s2 < 2; ++s2) {
        v4u pw; pw.x = pk2(s[8 * s2 + 0], s[8 * s2 + 1]); pw.y = pk2(s[8 * s2 + 2], s[8 * s2 + 3]); pw.z = pk2(s[8 * s2 + 4], s[8 * s2 + 5]); pw.w = pk2(s[8 * s2 + 6], s[8 * s2 + 7]);
        const bf16x8 pb = __builtin_bit_cast(bf16x8, pw);
        const bf16x8 a0 = __builtin_shufflevector(va[0][s2][0], va[0][s2][1], 0, 1, 2, 3, 4, 5, 6, 7);
        const bf16x8 a1 = __builtin_shufflevector(va[1][s2][0], va[1][s2][1], 0, 1, 2, 3, 4, 5, 6, 7);
        o0 = MFMA32(a0, pb, o0);
        o1 = MFMA32(a1, pb, o1);
    }
}
__device__ __forceinline__ void attn_block_lds(const LAS bf16* Kt, const LAS bf16* Vt, const bf16x8 (&qf)[4], f32x16& o0, f32x16& o1, float& m, float& l,
                                               int xbase, int lo, int hi, const LAS float* rp, int boff, int hh, int l31, int vs = 72) {
    const int krow = (l31 & 19) | ((l31 & 4) << 1) | ((l31 & 8) >> 1);
    bf16x8 kf[4];
#pragma unroll
    for (int ks = 0; ks < 4; ++ks) kf[ks] = *(const LAS bf16x8*)(Kt + krow * 72 + ks * 16 + hh * 8);
    bf16x8 vf[2][2];
#pragma unroll
    for (int dt = 0; dt < 2; ++dt)
#pragma unroll
        for (int s2 = 0; s2 < 2; ++s2) vf[dt][s2] = *(const LAS bf16x8*)(Vt + (dt * 32 + l31) * vs + 16 * s2 + 8 * hh);
    f32x16 s;
#pragma unroll
    for (int i = 0; i < 16; ++i) s[i] = 0.f;
#pragma unroll
    for (int ks = 0; ks < 4; ++ks) s = MFMA32(kf[ks], qf[ks], s);
    float mx = -3e38f;
    if (rp != nullptr) {
#pragma unroll
        for (int i = 0; i < 16; ++i) { const int x = xbase + (i & 3) + 4 * ((i >> 2) & 1) + 8 * hh + 16 * (i >> 3); const bool ok = x >= lo && x <= hi;
            const float bv = rp[ok ? x + boff : 0]; const float t = ok ? s[i] * SC2 + bv : -1e30f; s[i] = t; mx = fmaxf(mx, t); }
    } else {
#pragma unroll
        for (int i = 0; i < 16; ++i) { const int x = xbase + (i & 3) + 4 * ((i >> 2) & 1) + 8 * hh + 16 * (i >> 3); const bool ok = x >= lo && x <= hi;
            const float t = ok ? s[i] * SC2 : -1e30f; s[i] = t; mx = fmaxf(mx, t); }
    }
    mx = fmaxf(mx, __shfl_xor(mx, 32));
    const float mn = fmaxf(m, mx);
    const float alpha = __builtin_amdgcn_exp2f(m - mn);
    float rs = 0.f;
#pragma unroll
    for (int i = 0; i < 16; ++i) { s[i] = __builtin_amdgcn_exp2f(s[i] - mn); rs += s[i]; }
    rs += __shfl_xor(rs, 32);
    l = l * alpha + rs; m = mn;
#pragma unroll
    for (int i = 0; i < 16; ++i) { o0[i] *= alpha; o1[i] *= alpha; }
#pragma unroll
    for (int s2 = 0; s2 < 2; ++s2) {
        v4u pw; pw.x = pk2(s[8 * s2 + 0], s[8 * s2 + 1]); pw.y = pk2(s[8 * s2 + 2], s[8 * s2 + 3]); pw.z = pk2(s[8 * s2 + 4], s[8 * s2 + 5]); pw.w = pk2(s[8 * s2 + 6], s[8 * s2 + 7]);
        const bf16x8 pb = __builtin_bit_cast(bf16x8, pw);
        o0 = MFMA32(vf[0][s2], pb, o0);
        o1 = MFMA32(vf[1][s2], pb, o1);
    }
}
__device__ __forceinline__ void attn_store(const f32x16& o0, const f32x16& o1, float l, const bf16* zrow, bf16* yrow, int hh) {
    const float inv = 1.f / l;
#pragma unroll
    for (int dt = 0; dt < 2; ++dt)
#pragma unroll
        for (int g = 0; g < 4; ++g) {
            const int d = dt * 32 + 8 * g + 4 * hh;
            const v2u zz = *(const GAS v2u*)(zrow + d);
            float y[4];
#pragma unroll
            for (int e = 0; e < 4; ++e) { const float ov = (dt == 0 ? o0[4 * g + e] : o1[4 * g + e]) * inv; const float z = (e & 1) ? bfhi(e < 2 ? zz.x : zz.y) : bflo(e < 2 ? zz.x : zz.y); y[e] = ov * silu(z); }
            v2u w; w.x = pk2(y[0], y[1]); w.y = pk2(y[2], y[3]);
            *(GAS v2u*)(yrow + d) = w;
        }
}
__device__ __forceinline__ void load_q(bf16x8 (&qf)[4], const bf16* qrow, int hh) {
#pragma unroll
    for (int ks = 0; ks < 4; ++ks) qf[ks] = *(const GAS bf16x8*)(qrow + ks * 16 + hh * 8);
}

__device__ __forceinline__ void mixer_phase(const Params& p, int layer, LAS unsigned char* lds) {
    const int tid = opq_v(threadIdx.x), lane = tid & 63, wave = tid >> 6, hh = lane >> 5, l31 = lane & 31;
    const int bid = opq_s(bid);
    unsigned char* ws = opq_p(p.ws);
    const bf16* P = (const bf16*)(ws + WS_P); bf16* Y = (bf16*)(ws + WS_Y);
    const bf16* VTC = (const bf16*)(ws + WS_VTC); const bf16* VTD = (const bf16*)(ws + WS_VTD);
    const bf16* CKC = (const bf16*)(ws + WS_CKC); const bf16* CVTC = (const bf16*)(ws + WS_CVTC);
    const bf16* CKD = (const bf16*)(ws + WS_CKD); const bf16* CVTD = (const bf16*)(ws + WS_CVTD);
    LAS float* rpb_s = (LAS float*)lds;
    LAS bf16* vT = (LAS bf16*)(lds + 8192);
    { const GAS float* rpb = (const GAS float*)(opq_p(p.in[17]) + layer * 1860); for (int i = tid; i < 1860; i += 512) rpb_s[i] = rpb[i] * LOG2E; }
    __syncthreads();

    {
        const float* w_s = opq_p(p.in[13]) + (size_t)layer * 4 * 128 * 128; const GAS float* b_s = (const GAS float*)(opq_p(p.in[14]) + layer * 4 * 128);
        const bool balA = gridDim.x == 256;
        const int nA = balA ? (bid < 128 ? 3 : 0) : (384 - bid + (int)gridDim.x - 1) / (int)gridDim.x;
        for (int kA = 0; kA < nA; ++kA) {
            const int it = balA ? bid * 3 + kA : bid + kA * (int)gridDim.x;
            const int n = it >> 2, h = it & 3, row0 = n * 128;
            {
                const int q = tid >> 2, dq = (tid & 3) * 16;
                const bf16* src = P + (size_t)(row0 + q) * DIN + 256 + h * 64 + dq;
                const v4u a = *(const GAS v4u*)src, b = *(const GAS v4u*)(src + 8);
                float v[16];
                v[0] = bflo(a.x); v[1] = bfhi(a.x); v[2] = bflo(a.y); v[3] = bfhi(a.y); v[4] = bflo(a.z); v[5] = bfhi(a.z); v[6] = bflo(a.w); v[7] = bfhi(a.w);
                v[8] = bflo(b.x); v[9] = bfhi(b.x); v[10] = bflo(b.y); v[11] = bfhi(b.y); v[12] = bflo(b.z); v[13] = bfhi(b.z); v[14] = bflo(b.w); v[15] = bfhi(b.w);
                float ss = 0.f;
#pragma unroll
                for (int e = 0; e < 16; ++e) ss += v[e] * v[e];
                ss += __shfl_xor(ss, 1); ss += __shfl_xor(ss, 2);
                const float scl = rsqrtf(ss * (1.f / 64.f) + 1e-6f);
#pragma unroll
                for (int e = 0; e < 16; e += 2) { const unsigned w = pk2(v[e] * scl, v[e + 1] * scl); vT[(dq + e) * 136 + q] = (bf16)(w & 0xffff); vT[(dq + e + 1) * 136 + q] = (bf16)(w >> 16); }
            }
            __syncthreads();
            const int dt = wave & 1, pt = wave >> 1;
            f32x16 acc;
#pragma unroll
            for (int i = 0; i < 16; ++i) acc[i] = 0.f;
            const float* wrow = w_s + ((size_t)h * 128 + pt * 32 + l31) * 128 + hh * 8;
#pragma unroll
            for (int ks = 0; ks < 8; ++ks) {
                const bf16x8 A = *(const LAS bf16x8*)(vT + (dt * 32 + l31) * 136 + ks * 16 + hh * 8);
                const f32x4 w0 = *(const GAS f32x4*)(wrow + ks * 16), w1 = *(const GAS f32x4*)(wrow + ks * 16 + 4);
                v4u bw; bw.x = pk2(w0[0], w0[1]); bw.y = pk2(w0[2], w0[3]); bw.z = pk2(w1[0], w1[1]); bw.w = pk2(w1[2], w1[3]);
                acc = MFMA32(A, __builtin_bit_cast(bf16x8, bw), acc);
            }
            const int pp = pt * 32 + l31, row = row0 + pp;
            const float bias = b_s[h * 128 + pp];
#pragma unroll
            for (int g = 0; g < 4; ++g) {
                const int d = dt * 32 + 8 * g + 4 * hh;
                const v2u uu = *(const GAS v2u*)(P + (size_t)row * DIN + h * 64 + d), zz = *(const GAS v2u*)(P + (size_t)row * DIN + 512 + h * 64 + d);
                const float y0 = bflo(uu.x) * (acc[4 * g + 0] + bias) * silu(bflo(zz.x)), y1 = bfhi(uu.x) * (acc[4 * g + 1] + bias) * silu(bfhi(zz.x));
                const float y2 = bflo(uu.y) * (acc[4 * g + 2] + bias) * silu(bflo(zz.y)), y3 = bfhi(uu.y) * (acc[4 * g + 3] + bias) * silu(bfhi(zz.y));
                v2u w; w.x = pk2(y0, y1); w.y = pk2(y2, y3);
                *(GAS v2u*)(Y + (size_t)row * DM + h * 64 + d) = w;
            }
            __syncthreads();
        }
    }
    {
        const GAS float* wc = (const GAS float*)(opq_p(p.in[15]) + layer * 768);
        const bool balB = gridDim.x == 256;
        const int gt = bid * 512 + tid, NGT = balB ? 128 * 512 : (int)gridDim.x * 512;
        for (int idx = (balB && bid >= 128) ? NTOK * 32 : gt; idx < NTOK * 32; idx += NGT) {
            const int row = idx >> 5, c8 = (idx & 31) * 8;
            const int t = row < 4096 ? (row & 255) : ((row - 4096) & 4095), L = row < 4096 ? 256 : 4096;
            const bf16* pr = P + (size_t)row * DIN;
            const v4u bb = *(const GAS v4u*)(pr + 768 + c8), zz = *(const GAS v4u*)(pr + 1536 + c8);
            const v4u c1 = *(const GAS v4u*)(pr + 1024 + c8), h1 = *(const GAS v4u*)(pr + 1280 + c8);
            v4u c0 = {0u, 0u, 0u, 0u}, h0 = c0, c2 = c0, h2 = c0;
            if (t > 0) { c0 = *(const GAS v4u*)(pr - DIN + 1024 + c8); h0 = *(const GAS v4u*)(pr - DIN + 1280 + c8); }
            if (t < L - 1) { c2 = *(const GAS v4u*)(pr + DIN + 1024 + c8); h2 = *(const GAS v4u*)(pr + DIN + 1280 + c8); }
            unsigned ow[4];
#pragma unroll
            for (int e = 0; e < 4; ++e) {
                const unsigned wb = e == 0 ? bb.x : e == 1 ? bb.y : e == 2 ? bb.z : bb.w, wz = e == 0 ? zz.x : e == 1 ? zz.y : e == 2 ? zz.z : zz.w;
                const unsigned wc0 = e == 0 ? c0.x : e == 1 ? c0.y : e == 2 ? c0.z : c0.w, wh0 = e == 0 ? h0.x : e == 1 ? h0.y : e == 2 ? h0.z : h0.w;
                const unsigned wc1 = e == 0 ? c1.x : e == 1 ? c1.y : e == 2 ? c1.z : c1.w, wh1 = e == 0 ? h1.x : e == 1 ? h1.y : e == 2 ? h1.z : h1.w;
                const unsigned wc2 = e == 0 ? c2.x : e == 1 ? c2.y : e == 2 ? c2.z : c2.w, wh2 = e == 0 ? h2.x : e == 1 ? h2.y : e == 2 ? h2.z : h2.w;
                const int ch = c8 + 2 * e;
                const float ylo = bflo(wb) * (wc[ch] * (bflo(wc0) * bflo(wh0)) + wc[256 + ch] * (bflo(wc1) * bflo(wh1)) + wc[512 + ch] * (bflo(wc2) * bflo(wh2))) * silu(bflo(wz));
                const float yhi = bfhi(wb) * (wc[ch + 1] * (bfhi(wc0) * bfhi(wh0)) + wc[256 + ch + 1] * (bfhi(wc1) * bfhi(wh1)) + wc[512 + ch + 1] * (bfhi(wc2) * bfhi(wh2))) * silu(bfhi(wz));
                ow[e] = pk2(ylo, yhi);
            }
            v4u o; o.x = ow[0]; o.y = ow[1]; o.z = ow[2]; o.w = ow[3];
            *(GAS v4u*)(Y + (size_t)row * DM + 256 + c8) = o;
        }
    }
    const bool ctx_lds = gridDim.x == 256;
    if (ctx_lds && bid < 128) {
        const int it = bid, h8 = it & 7, b = it >> 3, h = h8 & 3; const bool isC = h8 < 4;
        const int row0 = b * 256, qrow = row0 + wave * 32 + l31;
        LAS bf16* const Kb = (LAS bf16*)(lds + 32768);
        LAS bf16* const Vb = Kb + 256 * 72;
        const int kcol = isC ? 2048 + (h >> 1) * 64 : 2816 + h * 64;
        const bf16* const vt0 = isC ? VTC + ((size_t)((b * 2 + (h >> 1)) * 64)) * 256 : VTD + ((size_t)((b * 4 + h) * 64)) * 256;
#pragma unroll
        for (int j = 0; j < 4; ++j) {
            const int c = tid + 512 * j;
            const v4u kv = *(const GAS v4u*)(P + (size_t)(row0 + (c >> 3)) * DIN + kcol + (c & 7) * 8);
            const v4u vv = *(const GAS v4u*)(vt0 + (size_t)(c >> 5) * 256 + (c & 31) * 8);
            *(LAS v4u*)(Kb + (c >> 3) * 72 + (c & 7) * 8) = kv;
            *(LAS v4u*)(Vb + (c >> 5) * 264 + (c & 31) * 8) = vv;
        }
        bf16x8 qf[4];
        load_q(qf, P + (size_t)qrow * DIN + (isC ? 1792 : 2560) + h * 64, hh);
        f32x16 o0, o1;
#pragma unroll
        for (int i = 0; i < 16; ++i) { o0[i] = 0.f; o1[i] = 0.f; }
        const GAS float* sinkp0 = (const GAS float*)(opq_p(p.in[16]) + layer * 4);
        float m = isC ? sinkp0[h] * LOG2E : -1e30f, l = isC ? 1.f : 0.f;
        __syncthreads();
#pragma unroll 1
        for (int kb = 0; kb < 8; ++kb)
            attn_block_lds(Kb + kb * 32 * 72, Vb + kb * 32, qf, o0, o1, m, l, 0, -(1 << 30), 1 << 30, nullptr, 0, hh, l31, 264);
        attn_store(o0, o1, l, P + (size_t)qrow * DIN + (isC ? 2304 : 3328) + h * 64, Y + (size_t)qrow * DM + (isC ? 512 : 768) + h * 64, hh);
        __syncthreads();
    }
    if (ctx_lds && bid < 128) {
        const int j8 = bid & 15, hq = (bid >> 4) & 3, b = bid >> 6, kvh = hq >> 1, q0 = j8 * 256;
        const int rowbase = 4096 + b * 4096, qpos0 = q0 + wave * 32, qpos = qpos0 + l31, qrow = rowbase + qpos;
        LAS bf16* const Kb = (LAS bf16*)(lds + 32768);
        LAS bf16* const Vb = Kb + 128 * 72;
        const size_t cb = (size_t)((b * 4 + layer) * 2 + kvh);
        const bf16* const kc = CKC + cb * 512 * 64; const bf16* const vc = CVTC + cb * 64 * 512;
        const bf16* const kl = P + (size_t)rowbase * DIN + 2048 + kvh * 64; const bf16* const vl = VTC + pg8::VTC_LAT + ((size_t)((b * 2 + kvh) * 64)) * 4096;
        const int lstart = max(q0 - 128, 0), lend = min(q0 + 384, 4096), nsteps = 4 + (lend - lstart) / 128;
        bf16x8 qf[4];
        load_q(qf, P + (size_t)qrow * DIN + 1792 + hq * 64, hh);
        f32x16 o0, o1;
#pragma unroll
        for (int i = 0; i < 16; ++i) { o0[i] = 0.f; o1[i] = 0.f; }
        const GAS float* sinkp1 = (const GAS float*)(opq_p(p.in[16]) + layer * 4);
        float m = sinkp1[hq] * LOG2E, l = 1.f;
#pragma unroll 1
        for (int s_ = 0; s_ < nsteps; ++s_) {
            const bool isctx = s_ < 4;
            const int t0 = isctx ? s_ * 128 : lstart + (s_ - 4) * 128;
#pragma unroll
            for (int j = 0; j < 2; ++j) {
                const int c = tid + 512 * j, key = c >> 3, kch = c & 7, d = c >> 4, vch = c & 15;
                const v4u kv = *(const GAS v4u*)(isctx ? kc + (size_t)(t0 + key) * 64 + kch * 8 : kl + (size_t)(t0 + key) * DIN + kch * 8);
                const v4u vv = *(const GAS v4u*)(isctx ? vc + (size_t)d * 512 + t0 + vch * 8 : vl + (size_t)d * 4096 + t0 + vch * 8);
                *(LAS v4u*)(Kb + key * 72 + kch * 8) = kv;
                *(LAS v4u*)(Vb + d * 136 + vch * 8) = vv;
            }
            __syncthreads();
#pragma unroll 1
            for (int q4 = 0; q4 < 4; ++q4) {
                const int kb0 = t0 + q4 * 32;
                if (isctx) attn_block_lds(Kb + q4 * 32 * 72, Vb + q4 * 32, qf, o0, o1, m, l, 0, -(1 << 30), 1 << 30, nullptr, 0, hh, l31, 136);
                else if (kb0 + 31 >= qpos0 - 128 && kb0 <= qpos0 + 159) attn_block_lds(Kb + q4 * 32 * 72, Vb + q4 * 32, qf, o0, o1, m, l, kb0, qpos - 128, qpos + 128, nullptr, 0, hh, l31, 136);
            }
            __syncthreads();
        }
        attn_store(o0, o1, l, P + (size_t)qrow * DIN + 2304 + hq * 64, Y + (size_t)qrow * DM + 512 + hq * 64, hh);
    }
    const int gw = bid * 8 + wave, NGW = gridDim.x * 8;
    const GAS float* sinkp = (const GAS float*)(opq_p(p.in[16]) + layer * 4);
    for (int it = gw; it < 2048; it += NGW) {
        if (ctx_lds && it < 1024) continue;
        f32x16 o0, o1;
#pragma unroll
        for (int i = 0; i < 16; ++i) { o0[i] = 0.f; o1[i] = 0.f; }
        bf16x8 qf[4];
        if (it < 1024) {
            const int jlo = it & 7, g = (it >> 3) & 1, jhi = (it >> 4) & 15, kvh = (it >> 8) & 1, b = it >> 9;
            const int hq = kvh * 2 + g, j = jhi * 8 + jlo, qpos0 = j * 32, rowbase = 4096 + b * 4096, qrow = rowbase + qpos0 + l31;
            load_q(qf, P + (size_t)qrow * DIN + 1792 + hq * 64, hh);
            float m = sinkp[hq] * LOG2E, l = 1.f;
            const size_t cb = (size_t)((b * 4 + layer) * 2 + kvh);
            for (int kb = 0; kb < 16; ++kb)
                attn_block(CKC + (cb * 512 + kb * 32 + l31) * 64, CVTC + (cb * 64 + l31) * 512 + kb * 32, 512, qf, o0, o1, m, l, MaskNone(), hh);
            for (int i = 0; i < 9; ++i) {
                const int k0 = qpos0 - 128 + 32 * i;
                if (k0 < 0 || k0 >= 4096) continue;
                MaskWin mw; mw.k0 = k0; mw.qpos = qpos0 + l31;
                attn_block(P + (size_t)(rowbase + k0 + l31) * DIN + 2048 + kvh * 64, VTC + pg8::VTC_LAT + ((size_t)((b * 2 + kvh) * 64 + l31)) * 4096 + k0, 4096, qf, o0, o1, m, l, mw, hh);
            }
            attn_store(o0, o1, l, P + (size_t)qrow * DIN + 2304 + hq * 64, Y + (size_t)qrow * DM + 512 + hq * 64, hh);
        } else {
            const int i2 = it - 1024, ch = i2 & 1, r = (i2 >> 1) & 63, h = (i2 >> 7) & 3, b = i2 >> 9;
            const int qc = ch * 32 + l31, rowbase = 4096 + b * 4096, qrow = rowbase + r * 64 + qc;
            load_q(qf, P + (size_t)qrow * DIN + 2560 + h * 64, hh);
            float m = -1e30f, l = 0.f;
            const size_t cb = (size_t)((b * 4 + layer) * 4 + h);
            for (int kb = 0; kb < 16; ++kb)
                attn_block(CKD + (cb * 512 + kb * 32 + l31) * 64, CVTD + (cb * 64 + l31) * 512 + kb * 32, 512, qf, o0, o1, m, l, MaskNone(), hh);
            const int rs = min(max(r - 4, 0), 56);
            const int cs = min(max(qc - 8, 0), 48);
            for (int i = 0; i < 16; ++i) {
                const int kr = rs + (i >> 1), kc0 = (i & 1) * 32, t0 = kr * 64 + kc0;
                MaskNb mb; mb.kc0 = kc0; mb.qc = qc; mb.cs = cs; mb.rp = rpb_s + h * 465 + (kr - r + 7) * 31;
                attn_block(P + (size_t)(rowbase + t0 + l31) * DIN + 2816 + h * 64, VTD + pg8::VTD_LAT + ((size_t)((b * 4 + h) * 64 + l31)) * 4096 + t0, 4096, qf, o0, o1, m, l, mb, hh);
            }
            attn_store(o0, o1, l, P + (size_t)qrow * DIN + 3328 + h * 64, Y + (size_t)qrow * DM + 768 + h * 64, hh);
        }
    }
    if (!ctx_lds)
    for (int it = gw; it < 1024; it += NGW) {
        const int qb = it & 7, h8 = (it >> 3) & 7, b = it >> 6;
        const bool isC = h8 < 4; const int h = h8 & 3;
        const int row0 = b * 256, qrow = row0 + qb * 32 + l31;
        f32x16 o0, o1;
#pragma unroll
        for (int i = 0; i < 16; ++i) { o0[i] = 0.f; o1[i] = 0.f; }
        bf16x8 qf[4];
        load_q(qf, P + (size_t)qrow * DIN + (isC ? 1792 : 2560) + h * 64, hh);
        float m = isC ? sinkp[h] * LOG2E : -1e30f, l = isC ? 1.f : 0.f;
        const int kcol = isC ? 2048 + (h >> 1) * 64 : 2816 + h * 64;
        const bf16* vtb = isC ? VTC + ((size_t)((b * 2 + (h >> 1)) * 64 + l31)) * 256 : VTD + ((size_t)((b * 4 + h) * 64 + l31)) * 256;
        for (int kb = 0; kb < 8; ++kb)
            attn_block(P + (size_t)(row0 + kb * 32 + l31) * DIN + kcol, vtb + kb * 32, 256, qf, o0, o1, m, l, MaskNone(), hh);
        attn_store(o0, o1, l, P + (size_t)qrow * DIN + (isC ? 2304 : 3328) + h * 64, Y + (size_t)qrow * DM + (isC ? 512 : 768) + h * 64, hh);
    }
}

#define GRID_SYNC() do { asm volatile("s_waitcnt vmcnt(0) lgkmcnt(0)" ::: "memory"); grid.sync(); if (threadIdx.x < 64) asm volatile("buffer_inv sc1\n\ts_waitcnt vmcnt(0)" ::: "memory"); __syncthreads(); } while (0)
__global__ void __launch_bounds__(512, 2) hybrid_fwd(Params p) {
    extern __shared__ __attribute__((aligned(16))) unsigned char lds_raw[];
    LAS unsigned char* lds = (LAS unsigned char*)lds_raw;
    cg::grid_group grid = cg::this_grid();

    prep_phase(p, lds);
    GRID_SYNC();
#pragma unroll 1
    for (int layer = 0; layer < NLAYER; ++layer) {
        unsigned char* ws = opq_p(p.ws);
        float* MOD = (float*)(ws + WS_MOD);
        bf16* H = (bf16*)(ws + WS_H); bf16* P = (bf16*)(ws + WS_P); bf16* Y = (bf16*)(ws + WS_Y); float* X = (float*)(ws + WS_X);
        bf16* WinT = (bf16*)(ws + WS_WIN); bf16* WoutT = (bf16*)(ws + WS_WOUT);
        const float* xc = layer == 0 ? opq_p(p.in[0]) : X;
        const float* xl = layer == 0 ? opq_p(p.in[1]) : X + (size_t)4096 * DM;
        norm_phase<false>(xc, xl, opq_p(p.in[8]) + layer * DM, MOD + layer * 9216, H, nullptr);
        GRID_SYNC();
        {
            pg8::Gemm g{H, WinT + (size_t)layer * DIN * DM, NTOK, DIN, DM}; pg8::StaticOrder S; S.init(NTOK, DIN, (int)gridDim.x, opq_s(blockIdx.x));
            pg8::EpiProj E{P, opq_p(p.out), (bf16*)(ws + WS_VTC), (bf16*)(ws + WS_VTD), layer};
            pg8::gemm_phase<pg8::EpiProj, pg8::StaticOrder, true, true>(lds, g, S, E);
        }
        GRID_SYNC();
        mixer_phase(p, layer, lds);
        GRID_SYNC();
        {
            pg8::Gemm g{Y, WoutT + (size_t)layer * DM * DM, NTOK, DM, DM}; pg8::StaticOrder S; S.init(NTOK, DM, (int)gridDim.x, opq_s(blockIdx.x));
            pg8::EpiOut E{xc, X, MOD + layer * 9216 + 2048, xl};
            pg8::gemm_phase<pg8::EpiOut, pg8::StaticOrder, true, true>(lds, g, S, E);
        }
        GRID_SYNC();
    }
    { float* X = (float*)(p.ws + WS_X); norm_phase<true>(X, X + (size_t)4096 * DM, p.in[18], nullptr, nullptr, p.out); }
}

extern "C" void kernel_launch(void* const* d_in, const int* in_sizes, int n_in, void* d_out, int out_size, void* d_ws, size_t ws_size, hipStream_t stream) {
    static int grid = 0;
    if (grid == 0) {
        if (n_in != 19 || ws_size < WS_END) { fprintf(stderr, "kernel_launch: unexpected inputs (n_in %d, ws %zu)\n", n_in, ws_size); grid = -1; return; }
        int dev = 0, cus = 0, per_cu = 0;
        hipGetDevice(&dev);
        hipDeviceGetAttribute(&cus, hipDeviceAttributeMultiprocessorCount, dev);
        if (hipFuncSetAttribute((const void*)hybrid_fwd, hipFuncAttributeMaxDynamicSharedMemorySize, LDS_BYTES) != hipSuccess) { fprintf(stderr, "kernel_launch: hipFuncSetAttribute failed\n"); grid = -1; return; }
        if (hipOccupancyMaxActiveBlocksPerMultiprocessor(&per_cu, (const void*)hybrid_fwd, 512, LDS_BYTES) != hipSuccess || per_cu < 1) { fprintf(stderr, "kernel_launch: occupancy query says %d\n", per_cu); per_cu = 1; (void)hipGetLastError(); }
        if (per_cu > 1) per_cu = 1;
        grid = cus * per_cu;
    }
    if (grid < 0) return;
    Params p{};
    for (int i = 0; i < 19; ++i) p.in[i] = (const float*)d_in[i];
    p.out = (float*)d_out; p.ws = (unsigned char*)d_ws;
    void* args[] = {&p};
    hipError_t e = hipLaunchCooperativeKernel((const void*)hybrid_fwd, dim3(grid), dim3(512), args, LDS_BYTES, stream);
    if (e != hipSuccess) fprintf(stderr, "cooperative launch failed: %s (grid %d)\n", hipGetErrorString(e), grid);
}
```
